# Optimizing an MI355X kernel written in HIP

```python
import jax
import jax.numpy as jnp
from jax import lax
import numpy as np

D_MODEL = 1024
BATCH = 4
SEQ = 8192
DEPTH = 2

CTX_LEN = 256
GRID_W = 64
MIX_WIDTH = D_MODEL
ATTN_HEAD_DIM = 64
ATTN_HEADS = MIX_WIDTH // (2 * ATTN_HEAD_DIM)
ATTN_KV_HEADS = ATTN_HEADS // 4
ATTN_GROUP = ATTN_HEADS // ATTN_KV_HEADS
ATTN_WIDTH = ATTN_HEADS * ATTN_HEAD_DIM
KV_WIDTH = ATTN_KV_HEADS * ATTN_HEAD_DIM
WINDOW = 128
BLOCK = 128
ROPE_BASE = 10000.0
RET_HEADS = 4
RET_WIDTH = MIX_WIDTH - ATTN_WIDTH
RET_V_DIM = RET_WIDTH // RET_HEADS
RET_QK_DIM = RET_V_DIM // 2
RET_QK_WIDTH = RET_HEADS * RET_QK_DIM
CHUNK = 128
IN_WIDTH = ATTN_WIDTH + 2 * KV_WIDTH + 2 * RET_QK_WIDTH + 2 * RET_WIDTH
D_FF = 256 * ((8 * D_MODEL // 3 + 255) // 256)
FFN_RESIDUAL = 0.5
N_MOD = 9
RMS_EPS = 1e-6
GN_EPS = 1e-5
NEG_INF = -1e30

kernel_name = 'hybrid_swa_retention_macaron_dit'


def rmsnorm(x, g):
    xf = x.astype(jnp.float32)
    y = xf * lax.rsqrt(jnp.mean(xf * xf, axis=-1, keepdims=True) + RMS_EPS)
    return (y * g.astype(jnp.float32)).astype(x.dtype)


def rotate(x, ang):
    f = ang.shape[-1]
    cs = jnp.cos(ang)[:, None, :].astype(x.dtype)
    sn = jnp.sin(ang)[:, None, :].astype(x.dtype)
    x1, x2 = x[..., :f], x[..., f:]
    return jnp.concatenate([x1 * cs - x2 * sn, x2 * cs + x1 * sn], axis=-1)


def axial_rope_angles(n_tokens):
    rows = n_tokens // GRID_W
    row = jnp.repeat(jnp.arange(rows, dtype=jnp.float32), GRID_W)
    col = jnp.tile(jnp.arange(GRID_W, dtype=jnp.float32), rows)
    nf = ATTN_HEAD_DIM // 4
    inv = ROPE_BASE ** (-jnp.arange(nf, dtype=jnp.float32) / nf)
    return row[:, None] * inv, col[:, None] * inv


def apply_axial(x, ang_row, ang_col):
    half = ATTN_HEAD_DIM // 2
    return jnp.concatenate([rotate(x[..., :half], ang_row), rotate(x[..., half:], ang_col)], axis=-1)


def retention_angles(n_tokens):
    t = jnp.arange(n_tokens, dtype=jnp.float32)
    inv = ROPE_BASE ** (-jnp.linspace(0.0, 1.0, RET_QK_DIM // 2, dtype=jnp.float32))
    return t[:, None] * inv


def swiglu_sublayer(h, shift, scale, gate, g_pre, g_post, wi, wo):
    u = rmsnorm(h, g_pre) * (1 + scale) + shift
    a, b = jnp.split(u @ wi, 2, axis=-1)
    y = (jax.nn.silu(a) * b) @ wo
    return h + FFN_RESIDUAL * gate * rmsnorm(y, g_post)


def project(u, w):
    b, t = u.shape[:2]
    sizes = [ATTN_WIDTH, KV_WIDTH, KV_WIDTH, RET_QK_WIDTH, RET_QK_WIDTH, RET_WIDTH, RET_WIDTH]
    qa, ka, va, qr, kr, vr, gr = jnp.split(u @ w, [int(o) for o in np.cumsum(sizes)[:-1]], axis=-1)
    qa = qa.reshape(b, t, ATTN_HEADS, ATTN_HEAD_DIM)
    ka = ka.reshape(b, t, ATTN_KV_HEADS, ATTN_HEAD_DIM)
    va = va.reshape(b, t, ATTN_KV_HEADS, ATTN_HEAD_DIM)
    qr = qr.reshape(b, t, RET_HEADS, RET_QK_DIM)
    kr = kr.reshape(b, t, RET_HEADS, RET_QK_DIM) * (RET_QK_DIM ** -0.5)
    vr = vr.reshape(b, t, RET_HEADS, RET_V_DIM)
    return qa, ka, va, qr, kr, vr, gr


def window_attention(q, k, v, k_ctx, v_ctx, sink):
    b, s = q.shape[:2]
    nb = s // BLOCK
    qb = q.reshape(b, nb, BLOCK, ATTN_KV_HEADS, ATTN_GROUP, ATTN_HEAD_DIM)

    def band(t):
        tp = jnp.pad(t, ((0, 0), (BLOCK, BLOCK), (0, 0), (0, 0)))
        tp = tp.reshape(b, nb + 2, BLOCK, ATTN_KV_HEADS, ATTN_HEAD_DIM)
        return jnp.concatenate([tp[:, :-2], tp[:, 1:-1], tp[:, 2:]], axis=2)

    kb, vb = band(k), band(v)
    qpos = jnp.arange(nb)[:, None] * BLOCK + jnp.arange(BLOCK)[None, :]
    kpos = (jnp.arange(nb)[:, None] - 1) * BLOCK + jnp.arange(3 * BLOCK)[None, :]
    rel = kpos[:, None, :] - qpos[:, :, None]
    valid = (jnp.abs(rel) <= WINDOW) & (kpos[:, None, :] >= 0) & (kpos[:, None, :] < s)
    scale = ATTN_HEAD_DIM ** -0.5
    s_loc = jnp.einsum('bnqkgd,bnskd->bnkgqs', qb, kb).astype(jnp.float32) * scale
    s_loc = jnp.where(valid[None, :, None, None], s_loc, NEG_INF)
    s_ctx = jnp.einsum('bnqkgd,blkd->bnkgql', qb, k_ctx).astype(jnp.float32) * scale
    sk = sink.astype(jnp.float32).reshape(ATTN_KV_HEADS, ATTN_GROUP)[None, None, :, :, None, None]
    m = jnp.maximum(jnp.maximum(s_loc.max(-1, keepdims=True), s_ctx.max(-1, keepdims=True)), sk)
    e_loc = jnp.exp(s_loc - m)
    e_ctx = jnp.exp(s_ctx - m)
    denom = e_loc.sum(-1, keepdims=True) + e_ctx.sum(-1, keepdims=True) + jnp.exp(sk - m)
    out = (jnp.einsum('bnkgqs,bnskd->bnqkgd', (e_loc / denom).astype(v.dtype), vb)
           + jnp.einsum('bnkgql,blkd->bnqkgd', (e_ctx / denom).astype(v.dtype), v_ctx))
    return out.reshape(b, s, ATTN_WIDTH)


def context_attention(q, k, v, sink):
    b, l = q.shape[:2]
    qg = q.reshape(b, l, ATTN_KV_HEADS, ATTN_GROUP, ATTN_HEAD_DIM)
    sc = jnp.einsum('blkgd,bmkd->bkglm', qg, k).astype(jnp.float32) * (ATTN_HEAD_DIM ** -0.5)
    sk = sink.astype(jnp.float32).reshape(ATTN_KV_HEADS, ATTN_GROUP)[None, :, :, None, None]
    m = jnp.maximum(sc.max(-1, keepdims=True), sk)
    e = jnp.exp(sc - m)
    p = e / (e.sum(-1, keepdims=True) + jnp.exp(sk - m))
    out = jnp.einsum('bkglm,bmkd->blkgd', p.astype(v.dtype), v)
    return out.reshape(b, l, ATTN_WIDTH)


def decay_tables(log_g, strict):
    idx = jnp.arange(CHUNK, dtype=jnp.float32)
    diff = idx[:, None] - idx[None, :]
    mask = diff > 0 if strict else diff >= 0
    intra = jnp.where(mask[None], jnp.exp(jnp.maximum(diff, 0.0)[None] * log_g[:, None, None]), 0.0)
    xi = jnp.exp((idx + 1.0)[None, :] * log_g[:, None])
    zeta = jnp.exp((CHUNK - 1.0 - idx)[None, :] * log_g[:, None])
    return intra, xi, zeta, jnp.exp(CHUNK * log_g)


def retention_dir(q, k, v, log_g, s0, strict):
    b, t = q.shape[:2]
    n = t // CHUNK
    qc = q.reshape(b, n, CHUNK, RET_HEADS, RET_QK_DIM)
    kc = k.reshape(b, n, CHUNK, RET_HEADS, RET_QK_DIM)
    vc = v.reshape(b, n, CHUNK, RET_HEADS, RET_V_DIM)
    intra, xi, zeta, chunk_decay = decay_tables(log_g, strict)
    scores = jnp.einsum('bnqhd,bnshd->bnhqs', qc, kc) * intra
    out_inner = jnp.einsum('bnhqs,bnshe->bnqhe', scores, vc)
    kv = jnp.einsum('bnshd,hs,bnshe->nbhde', kc, zeta, vc)

    def step(state, kv_i):
        return chunk_decay[None, :, None, None] * state + kv_i, state

    _, s_prev = lax.scan(step, s0, kv)
    out_cross = jnp.einsum('bnqhd,hq,nbhde->bnqhe', qc, xi, s_prev)
    return (out_inner + out_cross).reshape(b, t, RET_HEADS, RET_V_DIM)


def bidirectional_retention(q, k, v, log_f, log_b, s_f, s_b):
    flip = lambda a: a[:, ::-1]
    out_f = retention_dir(q, k, v, log_f, s_f, False)
    out_b = flip(retention_dir(flip(q), flip(k), flip(v), log_b, s_b, True))
    return out_f + out_b


def context_state(k, v, log_g, reverse):
    l = k.shape[1]
    idx = jnp.arange(l, dtype=jnp.float32)
    w = jnp.exp((idx if reverse else (l - 1.0 - idx))[None, :] * log_g[:, None])
    return jnp.einsum('blhd,hl,blhe->bhde', k, w, v)


def retention_output(y, g, gn_gain):
    b, t = y.shape[:2]
    yf = y.astype(jnp.float32)
    mu = yf.mean(-1, keepdims=True)
    var = ((yf - mu) ** 2).mean(-1, keepdims=True)
    yn = (yf - mu) * lax.rsqrt(var + GN_EPS) * gn_gain.astype(jnp.float32).reshape(RET_HEADS, RET_V_DIM)
    return (jax.nn.silu(g.astype(jnp.float32)) * yn.reshape(b, t, RET_WIDTH)).astype(g.dtype)


def setup_inputs(seed: int = 0) -> dict:
    key = jax.random.key(seed)
    ks = jax.random.split(key, 18)
    nrm = jax.random.normal
    f32 = jnp.float32
    base_logit = jnp.log(2.0 ** (5.0 + jnp.arange(RET_HEADS, dtype=f32)) - 1.0)
    return {
        'x': nrm(ks[0], (BATCH, SEQ, D_MODEL), f32),
        'c': nrm(ks[1], (BATCH, D_MODEL), f32),
        'ctx': nrm(ks[2], (BATCH, CTX_LEN, D_MODEL), f32),
        'c_ctx': nrm(ks[3], (D_MODEL,), f32),
        'ada_w': nrm(ks[4], (DEPTH, D_MODEL, N_MOD * D_MODEL), f32) * (0.5 * D_MODEL ** -0.5),
        'ada_b': nrm(ks[5], (DEPTH, N_MOD * D_MODEL), f32) * 0.01,
        'norm_pre': 1.0 + 0.05 * nrm(ks[6], (DEPTH, 3, D_MODEL), f32),
        'norm_post': 1.0 + 0.05 * nrm(ks[7], (DEPTH, 3, D_MODEL), f32),
        'ffn1_wi': nrm(ks[8], (DEPTH, D_MODEL, 2 * D_FF), f32) * D_MODEL ** -0.5,
        'ffn1_wo': nrm(ks[9], (DEPTH, D_FF, D_MODEL), f32) * D_FF ** -0.5,
        'ffn2_wi': nrm(ks[10], (DEPTH, D_MODEL, 2 * D_FF), f32) * D_MODEL ** -0.5,
        'ffn2_wo': nrm(ks[11], (DEPTH, D_FF, D_MODEL), f32) * D_FF ** -0.5,
        'w_in': nrm(ks[12], (DEPTH, D_MODEL, IN_WIDTH), f32) * D_MODEL ** -0.5,
        'w_out': nrm(ks[13], (DEPTH, MIX_WIDTH, D_MODEL), f32) * MIX_WIDTH ** -0.5,
        'attn_sink': 0.5 * nrm(ks[14], (DEPTH, ATTN_HEADS), f32),
        'ret_decay_fwd': base_logit + 0.05 * nrm(ks[15], (DEPTH, RET_HEADS), f32),
        'ret_decay_bwd': base_logit + 0.05 * nrm(ks[16], (DEPTH, RET_HEADS), f32),
        'ret_gn': 1.0 + 0.05 * nrm(ks[17], (DEPTH, RET_WIDTH), f32),
    }


def reference(x, c, ctx, c_ctx, ada_w, ada_b, norm_pre, norm_post, ffn1_wi, ffn1_wo, ffn2_wi, ffn2_wo,
              w_in, w_out, attn_sink, ret_decay_fwd, ret_decay_bwd, ret_gn):
    b, s = x.shape[:2]
    ang_row, ang_col = axial_rope_angles(s)
    ang_ret = retention_angles(s)
    h, hc = x, ctx
    for l in range(DEPTH):
        last = l == DEPTH - 1
        mod = (jax.nn.silu(c) @ ada_w[l] + ada_b[l]).reshape(b, N_MOD, 1, D_MODEL)
        mod_c = (jax.nn.silu(c_ctx) @ ada_w[l] + ada_b[l]).reshape(N_MOD, 1, D_MODEL)

        h = swiglu_sublayer(h, mod[:, 0], mod[:, 1], mod[:, 2], norm_pre[l, 0], norm_post[l, 0], ffn1_wi[l], ffn1_wo[l])
        hc = swiglu_sublayer(hc, mod_c[0], mod_c[1], mod_c[2], norm_pre[l, 0], norm_post[l, 0], ffn1_wi[l], ffn1_wo[l])

        u = rmsnorm(h, norm_pre[l, 1]) * (1 + mod[:, 4]) + mod[:, 3]
        uc = rmsnorm(hc, norm_pre[l, 1]) * (1 + mod_c[4]) + mod_c[3]
        qa, ka, va, qr, kr, vr, gr = project(u, w_in[l])
        qac, kac, vac, qrc, krc, vrc, grc = project(uc, w_in[l])
        log_f = jax.nn.log_sigmoid(ret_decay_fwd[l].astype(jnp.float32))
        log_b = jax.nn.log_sigmoid(ret_decay_bwd[l].astype(jnp.float32))
        s_f = context_state(krc, vrc, log_f, reverse=False)
        s_b = context_state(krc, vrc, log_b, reverse=True)

        attn = window_attention(apply_axial(qa, ang_row, ang_col), apply_axial(ka, ang_row, ang_col), va,
                                kac, vac, attn_sink[l])
        ret = retention_output(bidirectional_retention(rotate(qr, ang_ret), rotate(kr, ang_ret), vr,
                                                       log_f, log_b, s_f, s_b), gr, ret_gn[l])
        y = jnp.concatenate([attn, ret], axis=-1) @ w_out[l]
        h = h + mod[:, 5] * rmsnorm(y, norm_post[l, 1])

        if not last:
            zero_state = jnp.zeros((hc.shape[0], RET_HEADS, RET_QK_DIM, RET_V_DIM), jnp.float32)
            attn_c = context_attention(qac, kac, vac, attn_sink[l])
            ret_c = retention_output(bidirectional_retention(qrc, krc, vrc, log_f, log_b, zero_state, zero_state),
                                     grc, ret_gn[l])
            yc = jnp.concatenate([attn_c, ret_c], axis=-1) @ w_out[l]
            hc = hc + mod_c[5] * rmsnorm(yc, norm_post[l, 1])
            hc = swiglu_sublayer(hc, mod_c[6], mod_c[7], mod_c[8], norm_pre[l, 2], norm_post[l, 2], ffn2_wi[l], ffn2_wo[l])

        h = swiglu_sublayer(h, mod[:, 6], mod[:, 7], mod[:, 8], norm_pre[l, 2], norm_post[l, 2], ffn2_wi[l], ffn2_wo[l])
    return h
```

```cpp
#include <hip/hip_runtime.h>
#include <hip/hip_cooperative_groups.h>
#include <cstdio>
#include <cstdint>
namespace cg = cooperative_groups;
namespace pg8 {
#define PG8_LAS __attribute__((address_space(3)))
typedef unsigned short bf16_t;
typedef short bf16x8 __attribute__((ext_vector_type(8)));
typedef float f32x4 __attribute__((ext_vector_type(4)));
typedef unsigned u32x4 __attribute__((ext_vector_type(4)));
constexpr int BM = 256, BK = 64, HALF = 128, HTB = HALF * BK * 2  , STAGE_BYTES = 8 * HTB, NXCD = 8, WGM = 8;

__host__ __device__ __forceinline__ int lds_byte(int r, int c) { const int st = (r >> 4) * 2 + (c >> 5), rr = r & 15, cc = c & 31, ob = rr * 64 + cc * 2; return st * 1024 + (ob ^ (((ob >> 9) & 1) << 5)); }
__host__ __device__ __forceinline__ void stage_rc(int b, int& R, int& C) { const int st = b / 1024, sb = b % 1024, swz = sb ^ (((sb >> 9) & 1) << 5); R = (st >> 1) * 16 + swz / 64; C = (st & 1) * 32 + (swz % 64) / 2; }
__host__ __device__ __forceinline__ int perm32(int rho) { const int n = rho >> 4, i = rho & 15; return 8 * (i >> 2) + 4 * n + (i & 3); }

struct Unit { int pm, pn, ks; };
struct Gemm { const bf16_t* A; const bf16_t* Bt; int M, N, K, ld, ksplit; };

struct StaticOrder {
    int nM, nN, nwg, G, c;
    __host__ __device__ void init(int M, int N, int G_, int c_) { nM = M / BM; nN = N / BM; nwg = nM * nN; G = G_; c = c_; }
    __host__ __device__ bool next(int i, Unit& u) const {
        const long L = (long)i * G + c; if (L >= nwg) return false;
        int wgid = (int)L; { const int q = nwg / NXCD, r = nwg % NXCD, xcd = wgid % NXCD, off = wgid / NXCD; wgid = (xcd < r ? xcd * (q + 1) : r * (q + 1) + (xcd - r) * q) + off; }
        const int nig = WGM * nN, gid = wgid / nig, fm = gid * WGM, gsz = (nM - fm) < WGM ? (nM - fm) : WGM;
        u.pm = fm + ((wgid % nig) % gsz); u.pn = (wgid % nig) / gsz; u.ks = 0; return true;
    }
    __device__ __forceinline__ void a_ready(const Unit&) const {}
    __device__ __forceinline__ void done(const Unit&) const {}
};

__device__ __forceinline__ unsigned cvt_pk_bf16(float lo, float hi) { unsigned r; asm volatile("v_cvt_pk_bf16_f32 %0, %1, %2" : "=v"(r) : "v"(lo), "v"(hi)); return r; }
template <class Epi, class Sched, bool ALIGN_EPI = false, bool SP2 = false>
__device__ __forceinline__ void gemm_phase(PG8_LAS unsigned char* lds, const Gemm g, const Sched& S, const Epi& E) {
    int tid_ = threadIdx.x; asm volatile("" : "+v"(tid_)); const int tid = tid_, wid = __builtin_amdgcn_readfirstlane(tid >> 6), lane = tid & 63, wr = wid >> 2, wc = wid & 3, fr = lane & 15, fq = lane >> 4;
    const int K = g.K, nt = K / BK, LD = g.ld;
    unsigned voffA[2], voffB[2];
#pragma unroll
    for (int i = 0; i < 2; ++i) { int R, C; stage_rc(tid * 16 + i * 8192, R, C); const int Rb = Epi::PERM ? ((R & ~31) + perm32(R & 31)) : R;
        voffA[i] = (unsigned)(R * LD + C) * 2u; voffB[i] = (unsigned)(Rb * LD + C) * 2u; }
    const size_t kstep = (size_t)(BK * 2);
    const size_t hstep = (size_t)HALF * LD * 2;
    const size_t tstep = 2 * hstep;
    const unsigned ldsw = (unsigned)wid * 1024u;
    const int aoff = lds_byte(wr * 64 + fr, fq * 8), boff = lds_byte(wc * 32 + fr, fq * 8);
#define PG8_SA(b, h) (((b) * 2 + (h)) * HTB)
#define PG8_SB(b, h) ((4 + (b) * 2 + (h)) * HTB)
#define PG8_STAGE(bufoff, gbase, voff) do { _Pragma("unroll") for (int _i = 0; _i < 2; ++_i) \
        __builtin_amdgcn_global_load_lds((const unsigned*)((const char*)(gbase) + (voff)[_i]), (PG8_LAS unsigned*)(lds + (bufoff) + ldsw + _i * 8192), 16, 0, 0); } while (0)
#define PG8_LDA(dst, b, h) do { _Pragma("unroll") for (int m = 0; m < 4; ++m) _Pragma("unroll") for (int k = 0; k < 2; ++k) dst[m][k] = *(const PG8_LAS bf16x8*)(lds + PG8_SA(b, h) + aoff + m * 2048 + k * 1024); } while (0)
#define PG8_LDB(dst, b, h) do { _Pragma("unroll") for (int n = 0; n < 2; ++n) _Pragma("unroll") for (int k = 0; k < 2; ++k) dst[n][k] = *(const PG8_LAS bf16x8*)(lds + PG8_SB(b, h) + boff + n * 2048 + k * 1024); } while (0)
#define PG8_MMA(ai, bj, At, Bt) do { __builtin_amdgcn_s_setprio(1); _Pragma("unroll") for (int m = 0; m < 4; ++m) _Pragma("unroll") for (int n = 0; n < 2; ++n) _Pragma("unroll") for (int k = 0; k < 2; ++k) \
        acc[ai][bj][m][n] = __builtin_amdgcn_mfma_f32_16x16x32_bf16(Bt[n][k], At[m][k], acc[ai][bj][m][n], 0, 0, 0); __builtin_amdgcn_s_setprio(0); } while (0)
#define PG8_WAIT_V(n) asm volatile("s_waitcnt vmcnt(" #n ")" ::: "memory")
#define PG8_WAIT_L(n) asm volatile("s_waitcnt lgkmcnt(" #n ")" ::: "memory")
#define PG8_BAR __builtin_amdgcn_s_barrier()
#define PG8_SCHED __builtin_amdgcn_sched_barrier(0)
    Unit cur, nxt; int ui = 0;
    if (!S.next(0, cur)) return;
    f32x4 acc[2][2][4][2];
#pragma unroll
    for (int a = 0; a < 2; ++a)
#pragma unroll
        for (int b = 0; b < 2; ++b)
#pragma unroll
            for (int m = 0; m < 4; ++m)
#pragma unroll
                for (int n = 0; n < 2; ++n) acc[a][b][m][n] = (f32x4){0.f, 0.f, 0.f, 0.f};
    bf16x8 At[4][2], B0[2][2], B1[2][2];
    const char* cA = (const char*)g.A + (size_t)cur.pm * tstep + (size_t)cur.ks * g.ksplit * 2; const char* cB = (const char*)g.Bt + (size_t)cur.pn * tstep + (size_t)cur.ks * g.ksplit * 2;
    S.a_ready(cur);
    if constexpr (SP2) {
        PG8_STAGE(PG8_SB(0, 0), cB, voffB); PG8_STAGE(PG8_SB(0, 1), cB + hstep, voffB); PG8_STAGE(PG8_SA(0, 0), cA, voffA); PG8_STAGE(PG8_SA(0, 1), cA + hstep, voffA);
        if (wr == 1) PG8_BAR;
        PG8_WAIT_V(2); PG8_BAR;
        PG8_STAGE(PG8_SB(1, 0), cB + kstep, voffB); PG8_STAGE(PG8_SA(1, 0), cA + kstep, voffA); PG8_STAGE(PG8_SB(1, 1), cB + hstep + kstep, voffB);
        PG8_WAIT_V(6); PG8_BAR;
    } else {
        PG8_STAGE(PG8_SB(0, 0), cB, voffB); PG8_STAGE(PG8_SA(0, 0), cA, voffA); PG8_STAGE(PG8_SB(0, 1), cB + hstep, voffB); PG8_STAGE(PG8_SA(0, 1), cA + hstep, voffA);
        if (wr == 1) PG8_BAR;
        PG8_WAIT_V(4); PG8_BAR;
        PG8_STAGE(PG8_SB(1, 0), cB + kstep, voffB); PG8_STAGE(PG8_SA(1, 0), cA + kstep, voffA); PG8_STAGE(PG8_SB(1, 1), cB + hstep + kstep, voffB);
        PG8_WAIT_V(6); PG8_BAR;
    }
    for (;;) {
        const bool has_next = S.next(ui + 1, nxt);
        const char* nA = has_next ? (const char*)g.A + (size_t)nxt.pm * tstep + (size_t)nxt.ks * g.ksplit * 2 : cA; const char* nB = has_next ? (const char*)g.Bt + (size_t)nxt.pn * tstep + (size_t)nxt.ks * g.ksplit * 2 : cB;
        for (int t = 0; t < nt; t += 2) {
            const bool last = (t == nt - 2);
            const char* a1 = cA + (size_t)(t + 1) * kstep;
            const char* a2 = last ? nA : cA + (size_t)(t + 2) * kstep; const char* b2 = last ? nB : cB + (size_t)(t + 2) * kstep;
            const char* a3 = a2 + kstep; const char* b3 = b2 + kstep;
            if (last && has_next) S.a_ready(nxt);
            if constexpr (SP2) {
            PG8_LDB(B0, 0, 0); PG8_LDB(B1, 0, 1); PG8_SCHED; PG8_LDA(At, 0, 0); PG8_STAGE(PG8_SA(1, 1), a1 + hstep, voffA);
            PG8_WAIT_V(8); PG8_WAIT_L(0); PG8_BAR; PG8_MMA(0, 0, At, B0); PG8_MMA(0, 1, At, B1); PG8_BAR; PG8_SCHED;
            PG8_LDA(At, 0, 1); PG8_STAGE(PG8_SB(0, 0), b2, voffB); PG8_STAGE(PG8_SB(0, 1), b2 + hstep, voffB); PG8_STAGE(PG8_SA(0, 0), a2, voffA);
            PG8_WAIT_V(8); PG8_WAIT_L(0); PG8_BAR; PG8_MMA(1, 0, At, B0); PG8_MMA(1, 1, At, B1); PG8_BAR; PG8_SCHED;
            PG8_LDB(B0, 1, 0); PG8_LDB(B1, 1, 1); PG8_SCHED; PG8_LDA(At, 1, 0); PG8_STAGE(PG8_SA(0, 1), a2 + hstep, voffA);
            PG8_WAIT_V(8); PG8_WAIT_L(0); PG8_BAR; PG8_MMA(0, 0, At, B0); PG8_MMA(0, 1, At, B1); PG8_BAR; PG8_SCHED;
            PG8_LDA(At, 1, 1); PG8_STAGE(PG8_SB(1, 0), b3, voffB); PG8_STAGE(PG8_SB(1, 1), b3 + hstep, voffB); PG8_STAGE(PG8_SA(1, 0), a3, voffA);
            PG8_WAIT_V(8); PG8_WAIT_L(0); PG8_BAR; PG8_MMA(1, 0, At, B0); PG8_MMA(1, 1, At, B1); PG8_BAR; PG8_SCHED;
            } else {
            PG8_LDB(B0, 0, 0); PG8_SCHED; PG8_LDA(At, 0, 0); PG8_STAGE(PG8_SA(1, 1), a1 + hstep, voffA);
            PG8_WAIT_L(8); PG8_BAR; PG8_WAIT_L(0); PG8_MMA(0, 0, At, B0); PG8_BAR; PG8_SCHED;
            PG8_LDB(B1, 0, 1); PG8_STAGE(PG8_SB(0, 0), b2, voffB);
            PG8_BAR; PG8_WAIT_L(0); PG8_MMA(0, 1, At, B1); PG8_BAR;
            PG8_LDA(At, 0, 1); PG8_STAGE(PG8_SA(0, 0), a2, voffA);
            PG8_BAR; PG8_WAIT_L(0); PG8_MMA(1, 0, At, B0); PG8_BAR; PG8_SCHED;
            PG8_STAGE(PG8_SB(0, 1), b2 + hstep, voffB);
            PG8_WAIT_V(6); PG8_BAR; PG8_MMA(1, 1, At, B1); PG8_BAR;
            PG8_LDB(B0, 1, 0); PG8_SCHED; PG8_LDA(At, 1, 0); PG8_STAGE(PG8_SA(0, 1), a2 + hstep, voffA);
            PG8_WAIT_L(8); PG8_BAR; PG8_WAIT_L(0); PG8_MMA(0, 0, At, B0); PG8_BAR; PG8_SCHED;
            PG8_LDB(B1, 1, 1); PG8_STAGE(PG8_SB(1, 0), b3, voffB);
            PG8_BAR; PG8_WAIT_L(0); PG8_MMA(0, 1, At, B1); PG8_BAR;
            PG8_LDA(At, 1, 1); PG8_STAGE(PG8_SA(1, 0), a3, voffA);
            PG8_BAR; PG8_WAIT_L(0); PG8_MMA(1, 0, At, B0); PG8_BAR; PG8_SCHED;
            PG8_STAGE(PG8_SB(1, 1), b3 + hstep, voffB);
            PG8_WAIT_V(6); PG8_BAR; PG8_MMA(1, 1, At, B1); PG8_BAR;
            }
        }
        if constexpr (ALIGN_EPI) { if (wr == 0) PG8_BAR; }
        if constexpr (!Epi::AFTER_DRAIN) { E(acc, cur, wr, wc, fr, fq); S.done(cur); }
        if (!has_next) break;
#pragma unroll
        for (int a = 0; a < 2; ++a)
#pragma unroll
            for (int b = 0; b < 2; ++b)
#pragma unroll
                for (int m = 0; m < 4; ++m)
#pragma unroll
                    for (int n = 0; n < 2; ++n) acc[a][b][m][n] = (f32x4){0.f, 0.f, 0.f, 0.f};
        cur = nxt; cA = nA; cB = nB; ++ui;
        if constexpr (ALIGN_EPI) { if (wr == 1) PG8_BAR; }
    }
    PG8_WAIT_V(0);
    if constexpr (!ALIGN_EPI) { if (wr == 0) PG8_BAR; }
    PG8_BAR;
    if constexpr (Epi::AFTER_DRAIN) { E.fused(acc, cur, wr, wc, fr, fq, lds, wid, lane); S.done(cur); }
#undef PG8_SA
#undef PG8_SB
#undef PG8_STAGE
#undef PG8_LDA
#undef PG8_LDB
#undef PG8_MMA
#undef PG8_WAIT_V
#undef PG8_WAIT_L
#undef PG8_BAR
#undef PG8_SCHED
}
}

#define LAS __attribute__((address_space(3)))
using pg8::bf16_t; using pg8::bf16x8; using pg8::f32x4; using pg8::u32x4;
typedef unsigned u32x2 __attribute__((ext_vector_type(2)));
typedef float f32x2 __attribute__((ext_vector_type(2)));
typedef float f32x8 __attribute__((ext_vector_type(8)));

constexpr int DM = 1024, NBATCH = 4, SEQ = 8192, CTXL = 256;
constexpr int NLAT = NBATCH * SEQ, NCTX = NBATCH * CTXL, TROWS = NLAT + NCTX;
constexpr int DFF = 2816, NWI = 2 * DFF, INW = 2304, NMODC = 9 * DM;
constexpr int NTHREADS = 512;
constexpr int LDS_BYTES = 139264;
constexpr int C_QA = 0, C_KA = 512, C_VA = 640, C_QR = 768, C_KR = 1024, C_VR = 1280, C_GR = 1792;
constexpr int NCH = 264;
constexpr float RMS_EPS = 1e-6f, GN_EPS = 1e-5f;

constexpr size_t MiB = 1u << 20;
constexpr size_t SZ_WI = (size_t)NWI * DM * 2, SZ_WO = (size_t)DM * DFF * 2, SZ_WIN = (size_t)INW * DM * 2, SZ_WOUT = (size_t)DM * DM * 2;
constexpr size_t OW_WI1 = 0, OW_WO1 = SZ_WI, OW_WIN = OW_WO1 + SZ_WO, OW_WOUT = OW_WIN + SZ_WIN, OW_WI2 = OW_WOUT + SZ_WOUT, OW_WO2 = OW_WI2 + SZ_WI, SZ_WL = OW_WO2 + SZ_WO;
static_assert(2 * SZ_WL <= 79 * MiB, "weights");
constexpr size_t WS_W = 0, WS_MOD = 79 * MiB, WS_RET = 80 * MiB, WS_AX = 82 * MiB, WS_HC = 83 * MiB, WS_U = 87 * MiB, WS_Y = 153 * MiB, WS_MIX = 219 * MiB, WS_ACT = 285 * MiB;
constexpr size_t WS_BAR = 82 * MiB + 512 * 1024;
constexpr size_t WS_H = WS_MIX;
constexpr size_t WS_KV = WS_Y, WS_SP = WS_Y + 33 * MiB;
static_assert((size_t)TROWS * DM * 2 == 66 * MiB && (size_t)2 * NCH * 4 * 8192 * 2 == 33 * MiB, "overlay sizes");
constexpr size_t WS_KT = WS_ACT + (size_t)TROWS * INW * 2;
constexpr size_t WS_VT = WS_ACT + (size_t)TROWS * DFF * 2;
static_assert(WS_KT + (size_t)256 * TROWS * 2 <= WS_VT, "kr^T fits behind proj");
constexpr size_t WS_PART = WS_VT;
constexpr size_t WS_END = WS_PART + (size_t)11 * NCTX * DM * 4;
static_assert(WS_END >= WS_VT + (size_t)640 * TROWS * 2 && WS_END <= 512 * MiB, "workspace");

struct Params { const float* in[18]; float* out; unsigned char* ws; };

__device__ __forceinline__ unsigned f2bf(float f) { unsigned u = __builtin_bit_cast(unsigned, f); return (u + 0x7fffu + ((u >> 16) & 1u)) >> 16; }
__device__ __forceinline__ unsigned pk2(float lo, float hi) { return pg8::cvt_pk_bf16(lo, hi); }
__device__ __forceinline__ float bflo(unsigned u) { return __builtin_bit_cast(float, u << 16); }
__device__ __forceinline__ float bfhi(unsigned u) { return __builtin_bit_cast(float, u & 0xffff0000u); }
__device__ __forceinline__ float bf2f(bf16_t b) { return __builtin_bit_cast(float, (unsigned)b << 16); }
__device__ __forceinline__ f32x8 unpack8(u32x4 v) { f32x8 o; o[0] = bflo(v.x); o[1] = bfhi(v.x); o[2] = bflo(v.y); o[3] = bfhi(v.y); o[4] = bflo(v.z); o[5] = bfhi(v.z); o[6] = bflo(v.w); o[7] = bfhi(v.w); return o; }
__device__ __forceinline__ u32x4 pack8(f32x8 v) { u32x4 o; o.x = pk2(v[0], v[1]); o.y = pk2(v[2], v[3]); o.z = pk2(v[4], v[5]); o.w = pk2(v[6], v[7]); return o; }
__device__ __forceinline__ float silu_f(float a) { return a * __builtin_amdgcn_rcpf(1.f + __expf(-a)); }
__device__ __forceinline__ float wave_sum(float v) {
#pragma unroll
    for (int o = 1; o < 64; o <<= 1) v += __shfl_xor(v, o);
    return v;
}
__device__ __forceinline__ float sum16(float v) { v += __shfl_xor(v, 1); v += __shfl_xor(v, 2); v += __shfl_xor(v, 4); v += __shfl_xor(v, 8); return v; }
__device__ __forceinline__ float max16(float v) { v = fmaxf(v, __shfl_xor(v, 1)); v = fmaxf(v, __shfl_xor(v, 2)); v = fmaxf(v, __shfl_xor(v, 4)); v = fmaxf(v, __shfl_xor(v, 8)); return v; }
__device__ __forceinline__ float logsig(float x) { return -log1pf(__expf(-x)); }
#define LDS_WAIT() asm volatile("s_waitcnt lgkmcnt(0)" ::: "memory")
#define WAVE_FENCE() do { asm volatile("s_waitcnt lgkmcnt(0)" ::: "memory"); __builtin_amdgcn_wave_barrier(); } while (0)

__device__ __forceinline__ int off64(int row, int col) { return row * 128 + ((((col >> 3) ^ (row & 7)) << 4) | ((col & 7) << 1)); }
__device__ __forceinline__ int off128(int row, int col) { return row * 256 + ((((col >> 3) ^ (row & 7)) << 4) | ((col & 7) << 1)); }
__device__ __forceinline__ bf16x8 lds_ld16(LAS unsigned char* base, int off) { return *(LAS bf16x8*)(base + off); }
__device__ __forceinline__ void lds_st16(LAS unsigned char* base, int off, u32x4 v) { *(LAS u32x4*)(base + off) = v; }
__device__ __forceinline__ void lds_st2(LAS unsigned char* base, int off, unsigned v) { *(LAS unsigned short*)(base + off) = (unsigned short)v; }
__device__ __forceinline__ f32x4 mfma16(bf16x8 a, bf16x8 b, f32x4 c) { return __builtin_amdgcn_mfma_f32_16x16x32_bf16(a, b, c, 0, 0, 0); }

__device__ __forceinline__ f32x8 load8(const bf16_t* rowptr, int c, int mode, const f32x2* cs) {
    f32x8 o = unpack8(*(const u32x4*)(rowptr + c * 8));
    if (mode) {
        const int pc = (mode == 1) ? (c ^ 2) : (c ^ 4);
        const bool isx2 = (mode == 1) ? ((c >> 1) & 1) : ((c >> 2) & 1);
        const f32x8 pp = unpack8(*(const u32x4*)(rowptr + pc * 8));
#pragma unroll
        for (int j = 0; j < 8; ++j) { const f32x2 t = cs[j]; o[j] = o[j] * t.x + (isx2 ? pp[j] : -pp[j]) * t.y; }
    }
    return o;
}

struct EpiStoreBf16 {
    static constexpr bool PERM = true, AFTER_DRAIN = false;
    bf16_t* O; int ldc;
    __device__ __forceinline__ void operator()(const f32x4 (&acc)[2][2][4][2], const pg8::Unit& u, int wr, int wc, int fr, int fq) const {
        const int row0 = u.pm * 256 + wr * 64 + fr, col0 = u.pn * 256 + wc * 32 + 8 * fq;
#pragma unroll
        for (int ai = 0; ai < 2; ++ai)
#pragma unroll
            for (int m = 0; m < 4; ++m) { bf16_t* rowp = O + (size_t)(row0 + ai * 128 + m * 16) * ldc + col0;
#pragma unroll
                for (int bj = 0; bj < 2; ++bj) { const f32x4 v0 = acc[ai][bj][m][0], v1 = acc[ai][bj][m][1];
                    u32x4 w; w.x = pk2(v0[0], v0[1]); w.y = pk2(v0[2], v0[3]); w.z = pk2(v1[0], v1[1]); w.w = pk2(v1[2], v1[3]);
                    *(u32x4*)(rowp + bj * 128) = w; } }
    }
};
struct EpiSwiglu {
    static constexpr bool PERM = true, AFTER_DRAIN = false;
    bf16_t* O;
    __device__ __forceinline__ void operator()(const f32x4 (&acc)[2][2][4][2], const pg8::Unit& u, int wr, int wc, int fr, int fq) const {
        const int row0 = u.pm * 256 + wr * 64 + fr, col0 = u.pn * 128 + wc * 32 + 8 * fq;
#pragma unroll
        for (int ai = 0; ai < 2; ++ai)
#pragma unroll
            for (int m = 0; m < 4; ++m) { bf16_t* rowp = O + (size_t)(row0 + ai * 128 + m * 16) * DFF + col0;
                const f32x4 a0 = acc[ai][0][m][0], a1 = acc[ai][0][m][1], b0 = acc[ai][1][m][0], b1 = acc[ai][1][m][1];
                u32x4 w; w.x = pk2(silu_f(a0[0]) * b0[0], silu_f(a0[1]) * b0[1]); w.y = pk2(silu_f(a0[2]) * b0[2], silu_f(a0[3]) * b0[3]);
                w.z = pk2(silu_f(a1[0]) * b1[0], silu_f(a1[1]) * b1[1]); w.w = pk2(silu_f(a1[2]) * b1[2], silu_f(a1[3]) * b1[3]);
                *(u32x4*)rowp = w; }
    }
};

__device__ __forceinline__ void transpose_item(const float* W, int K, int N, bf16_t* WT, int mode, LAS float* scr, int item, int lane) {
    const int nblk = N / 32, kb = item / nblk, nb = item % nblk, k0 = 64 * kb, n0 = 32 * nb;
#pragma unroll 8
    for (int i = 0; i < 32; ++i) { const int kk = 2 * i + (lane >> 5); scr[kk * 33 + (lane & 31)] = W[(size_t)(k0 + kk) * N + n0 + (lane & 31)]; }
    LDS_WAIT();
    int on0 = n0; float sc = 1.f;
    if (mode == 1) { if (n0 < DFF) on0 = (n0 >> 7) * 256 + (n0 & 127); else { const int mm = n0 - DFF; on0 = (mm >> 7) * 256 + 128 + (mm & 127); } }
    else if (mode == 2) { if (n0 < 512 || (n0 >= C_KR && n0 < C_VR)) sc = 0.125f; }
    const int c = lane & 7;
#pragma unroll
    for (int j = 0; j < 4; ++j) { const int n = (lane >> 3) + 8 * j; const LAS float* s = scr + (8 * c) * 33 + n;
        u32x4 o; o.x = pk2(s[0 * 33] * sc, s[1 * 33] * sc); o.y = pk2(s[2 * 33] * sc, s[3 * 33] * sc); o.z = pk2(s[4 * 33] * sc, s[5 * 33] * sc); o.w = pk2(s[6 * 33] * sc, s[7 * 33] * sc);
        int orow = on0 + n;
        if (mode == 2) { const int sc_ = n0 + n, d = sc_ & 63;
            if (sc_ < 640) { const int dd = d & 31; orow = (sc_ & ~63) + 8 * ((d >> 5) * 4 + ((dd & 15) >> 2)) + 4 * (dd >> 4) + (dd & 3); }
            else if (sc_ >= C_QR && sc_ < C_VR) { const int ff = d & 31; orow = (sc_ & ~63) + 8 * (ff >> 2) + 4 * (d >> 5) + (ff & 3); } }
        *(u32x4*)(WT + (size_t)orow * K + k0 + 8 * c) = o; }
    LDS_WAIT();
}

__device__ __forceinline__ void sincos_tab(float angf, float& s, float& c) {
    const double a = (double)angf; const double q = rint(a * 0.63661977236758134308);
    const double r = fma(-q, 1.57079632679489661923, a), r2 = r * r;
    const double sp = r * (1.0 + r2 * (-1.0 / 6.0 + r2 * (1.0 / 120.0 + r2 * (-1.0 / 5040.0 + r2 * (1.0 / 362880.0 + r2 * (-1.0 / 39916800.0 + r2 * (1.0 / 6227020800.0)))))));
    const double cp = 1.0 + r2 * (-0.5 + r2 * (1.0 / 24.0 + r2 * (-1.0 / 720.0 + r2 * (1.0 / 40320.0 + r2 * (-1.0 / 3628800.0 + r2 * (1.0 / 479001600.0))))));
    const int qi = ((int)q) & 3;
    const double ss = (qi == 0) ? sp : (qi == 1) ? cp : (qi == 2) ? -sp : -cp;
    const double cc = (qi == 0) ? cp : (qi == 1) ? -sp : (qi == 2) ? -cp : sp;
    s = (float)ss; c = (float)cc;
}

__device__ __forceinline__ void p0_phase(const Params& p, LAS unsigned char* lds, int tid, int lane, int wave) {
    unsigned char* ws = p.ws;
    {
        LAS float* scr = (LAS float*)(lds + wave * 16384);
        const int gw = blockIdx.x * 8 + wave, NGW = gridDim.x * 8;
        constexpr int I_WI = (DM / 64) * (NWI / 32), I_WO = (DFF / 64) * (DM / 32), I_WIN = (DM / 64) * (INW / 32), I_WOUT = (DM / 64) * (DM / 32);
        constexpr int LT = 2 * I_WI + 2 * I_WO + I_WIN + I_WOUT;
        for (int it = gw; it < 2 * LT; it += NGW) {
            const int l = it / LT; int r = it % LT;
            bf16_t* wl = (bf16_t*)(ws + WS_W + (size_t)l * SZ_WL);
            if (r < I_WI) { transpose_item(p.in[8] + (size_t)l * DM * NWI, DM, NWI, wl + OW_WI1 / 2, 1, scr, r, lane); continue; } r -= I_WI;
            if (r < I_WO) { transpose_item(p.in[9] + (size_t)l * DFF * DM, DFF, DM, wl + OW_WO1 / 2, 0, scr, r, lane); continue; } r -= I_WO;
            if (r < I_WIN) { transpose_item(p.in[12] + (size_t)l * DM * INW, DM, INW, wl + OW_WIN / 2, 2, scr, r, lane); continue; } r -= I_WIN;
            if (r < I_WOUT) { transpose_item(p.in[13] + (size_t)l * DM * DM, DM, DM, wl + OW_WOUT / 2, 0, scr, r, lane); continue; } r -= I_WOUT;
            if (r < I_WI) { transpose_item(p.in[10] + (size_t)l * DM * NWI, DM, NWI, wl + OW_WI2 / 2, 1, scr, r, lane); continue; } r -= I_WI;
            transpose_item(p.in[11] + (size_t)l * DFF * DM, DFF, DM, wl + OW_WO2 / 2, 0, scr, r, lane);
        }
    }
    __syncthreads();
    {
        LAS float* sil = (LAS float*)lds;
        LAS float* red = (LAS float*)(lds + 32768);
        float* mod = (float*)(ws + WS_MOD);
        for (int i = tid; i < 5 * DM; i += NTHREADS) { const int set = i >> 10, k = i & 1023; const float v = set < 4 ? p.in[1][set * DM + k] : p.in[3][k]; sil[i] = v / (1.f + __expf(-v)); }
        __syncthreads();
        const int kg = tid >> 6, jc = tid & 63;
        for (int ch = blockIdx.x; ch < 2 * (NMODC / 64); ch += gridDim.x) {
            const int l = ch / (NMODC / 64), j0 = (ch % (NMODC / 64)) * 64;
            const float* wp = p.in[4] + ((size_t)l * DM + kg * 128) * NMODC + j0 + jc;
            float a0 = 0.f, a1 = 0.f, a2 = 0.f, a3 = 0.f, a4 = 0.f;
#pragma unroll 32
            for (int k = 0; k < 128; ++k) { const float w = wp[(size_t)k * NMODC]; const int kk = kg * 128 + k;
                a0 += sil[kk] * w; a1 += sil[1024 + kk] * w; a2 += sil[2048 + kk] * w; a3 += sil[3072 + kk] * w; a4 += sil[4096 + kk] * w; }
            red[(kg * 5 + 0) * 64 + jc] = a0; red[(kg * 5 + 1) * 64 + jc] = a1; red[(kg * 5 + 2) * 64 + jc] = a2; red[(kg * 5 + 3) * 64 + jc] = a3; red[(kg * 5 + 4) * 64 + jc] = a4;
            __syncthreads();
            if (tid < 320) { const int s = tid >> 6; float v = p.in[5][l * NMODC + j0 + jc];
#pragma unroll
                for (int g = 0; g < 8; ++g) v += red[(g * 5 + s) * 64 + jc];
                mod[(size_t)(l * 5 + s) * NMODC + j0 + jc] = v; }
            __syncthreads();
        }
    }
    {
        static const float inv32[32] = {1.000000000e+00f, 7.429639697e-01f, 5.519954562e-01f, 4.101127088e-01f, 3.046989739e-01f, 2.263803482e-01f, 1.681924462e-01f, 1.249609217e-01f,
            9.284146130e-02f, 6.897786260e-02f, 5.124806240e-02f, 3.807546198e-02f, 2.828869782e-02f, 2.101748250e-02f, 1.561523229e-02f, 1.160155516e-02f,
            8.619536646e-03f, 6.404003594e-03f, 4.757944960e-03f, 3.534980817e-03f, 2.626364119e-03f, 1.951293205e-03f, 1.449740957e-03f, 1.077104942e-03f,
            8.002503891e-04f, 5.945570301e-04f, 4.417345626e-04f, 3.281927784e-04f, 2.438354713e-04f, 1.811609254e-04f, 1.345960773e-04f, 9.999999747e-05f};
        static const float inv16[16] = {1.000000000e+00f, 5.623413324e-01f, 3.162277639e-01f, 1.778279394e-01f, 1.000000015e-01f, 5.623413250e-02f, 3.162277490e-02f, 1.778279431e-02f,
            9.999999776e-03f, 5.623413250e-03f, 3.162277630e-03f, 1.778279431e-03f, 1.000000047e-03f, 5.623413017e-04f, 3.162277571e-04f, 1.778279402e-04f};
        f32x2* rt = (f32x2*)(ws + WS_RET); f32x2* ax = (f32x2*)(ws + WS_AX);
        const int gt = blockIdx.x * NTHREADS + tid, NT = gridDim.x * NTHREADS;
        for (int i = gt; i < SEQ * 32 + 192 * 16; i += NT) {
            float ang; f32x2* dst;
            if (i < SEQ * 32) { ang = (float)(i >> 5) * inv32[i & 31]; dst = rt + i; }
            else { const int j = i - SEQ * 32, idx = j >> 4; ang = (float)(idx < 128 ? idx : idx - 128) * inv16[j & 15]; dst = ax + j; }
            float s, c; sincos_tab(ang, s, c); *dst = (f32x2){c, s};
        }
    }
}

__device__ __forceinline__ void norm_phase(int nrows, const bf16_t* __restrict__ y, const bf16_t* __restrict__ ypart, int nsplit, const float* __restrict__ hs_lat, const float* __restrict__ hs_ctx, bf16_t* hb, float* __restrict__ out_f32,
                                           float rs, const float* __restrict__ mod_g, int gate_idx, const float* __restrict__ gpost,
                                           bool do_u, const float* __restrict__ mod_u, int shift_idx, int scale_idx, const float* __restrict__ gpre, bf16_t* __restrict__ u, int lane, int wave) {
    const int gw = blockIdx.x * 8 + wave, NGW = gridDim.x * 8, nlatch = NLAT >> 4, nitems = nlatch + (nrows - NLAT);
    for (int ch = gw; ch < nitems; ch += NGW) {
        const bool single = ch >= nlatch;
        const int row0 = single ? NLAT + (ch - nlatch) : ch * 16, set = row0 < NLAT ? row0 / SEQ : 4;
        f32x4 gg[4], pa[4], pb[4];
#pragma unroll
        for (int j = 0; j < 4; ++j) { const int col = 4 * lane + 256 * j;
            if (y) gg[j] = *(const f32x4*)(mod_g + (size_t)set * NMODC + gate_idx * DM + col) * *(const f32x4*)(gpost + col) * rs;
            if (do_u) { pa[j] = *(const f32x4*)(gpre + col) * (*(const f32x4*)(mod_u + (size_t)set * NMODC + scale_idx * DM + col) + 1.f); pb[j] = *(const f32x4*)(mod_u + (size_t)set * NMODC + shift_idx * DM + col); } }
#pragma unroll 1
        for (int g = 0; g < (single ? 4 : 16); g += 4) {
            f32x4 hv[4][4]; u32x2 yw[4][4];
#pragma unroll
            for (int q = 0; q < 4; ++q) { if (single && q > 0) continue;
                const int row = single ? row0 : row0 + g + q;
                if (hs_lat) { const float* hs = row < NLAT ? hs_lat + (size_t)row * DM : hs_ctx + (size_t)(row - NLAT) * DM;
#pragma unroll
                    for (int j = 0; j < 4; ++j) hv[q][j] = *(const f32x4*)(hs + 4 * lane + 256 * j); }
                else {
#pragma unroll
                    for (int j = 0; j < 4; ++j) { const u32x2 w = *(const u32x2*)(hb + (size_t)row * DM + 4 * lane + 256 * j); hv[q][j] = (f32x4){bflo(w.x), bfhi(w.x), bflo(w.y), bfhi(w.y)}; } }
                if (y && !(single && ypart)) {
#pragma unroll
                    for (int j = 0; j < 4; ++j) yw[q][j] = *(const u32x2*)(y + (size_t)row * DM + 4 * lane + 256 * j);
                } }
#pragma unroll
            for (int q = 0; q < 4; ++q) { if (single && q > 0) continue;
                const int row = single ? row0 : row0 + g + q;
                if (y) {
                    f32x4 yv[4]; float ss = 0.f;
                    if (single && ypart) {
#pragma unroll
                        for (int j = 0; j < 4; ++j) yv[j] = (f32x4){0.f, 0.f, 0.f, 0.f};
#pragma unroll 1
                        for (int sp0 = 0; sp0 < nsplit; sp0 += 6) {
                            u32x2 t[6][4];
#pragma unroll
                            for (int s4 = 0; s4 < 6; ++s4) { const int sp_ = (sp0 + s4 < nsplit) ? sp0 + s4 : sp0;
#pragma unroll
                                for (int j = 0; j < 4; ++j) t[s4][j] = *(const u32x2*)(ypart + ((size_t)sp_ * NCTX + (row - NLAT)) * DM + 4 * lane + 256 * j); }
#pragma unroll
                            for (int s4 = 0; s4 < 6; ++s4) { if (sp0 + s4 < nsplit) {
#pragma unroll
                                for (int j = 0; j < 4; ++j) yv[j] = yv[j] + (f32x4){bflo(t[s4][j].x), bfhi(t[s4][j].x), bflo(t[s4][j].y), bfhi(t[s4][j].y)}; } }
                        }
                    }
#pragma unroll
                    for (int j = 0; j < 4; ++j) { const u32x2 w = yw[q][j];
                        if (!(single && ypart)) yv[j] = (f32x4){bflo(w.x), bfhi(w.x), bflo(w.y), bfhi(w.y)};
                        ss += (yv[j].x * yv[j].x + yv[j].y * yv[j].y) + (yv[j].z * yv[j].z + yv[j].w * yv[j].w); }
                    const float r = __builtin_amdgcn_rsqf(wave_sum(ss) * (1.f / DM) + RMS_EPS);
#pragma unroll
                    for (int j = 0; j < 4; ++j) { const int col = 4 * lane + 256 * j;
                        hv[q][j] = hv[q][j] + (yv[j] * r) * gg[j];
                        if (out_f32) *(f32x4*)(out_f32 + (size_t)row * DM + col) = hv[q][j];
                        else { u32x2 w; w.x = pk2(hv[q][j].x, hv[q][j].y); w.y = pk2(hv[q][j].z, hv[q][j].w); *(u32x2*)(hb + (size_t)row * DM + col) = w;
                               hv[q][j] = (f32x4){bflo(w.x), bfhi(w.x), bflo(w.y), bfhi(w.y)}; } }
                }
                if (do_u) {
                    float ss = 0.f;
#pragma unroll
                    for (int j = 0; j < 4; ++j) ss += (hv[q][j].x * hv[q][j].x + hv[q][j].y * hv[q][j].y) + (hv[q][j].z * hv[q][j].z + hv[q][j].w * hv[q][j].w);
                    const float r = __builtin_amdgcn_rsqf(wave_sum(ss) * (1.f / DM) + RMS_EPS);
#pragma unroll
                    for (int j = 0; j < 4; ++j) { const int col = 4 * lane + 256 * j;
                        const f32x4 o = (hv[q][j] * r) * pa[j] + pb[j];
                        u32x2 w; w.x = pk2(o.x, o.y); w.y = pk2(o.z, o.w); *(u32x2*)(u + (size_t)row * DM + col) = w; }
                }
            }
        }
    }
}

__device__ __forceinline__ void norm_phase8(int nrows, const bf16_t* __restrict__ y, const bf16_t* __restrict__ ypart, int nsplit, const float* __restrict__ hs_lat, const float* __restrict__ hs_ctx, bf16_t* hb, float* __restrict__ out_f32,
                                           float rs, const float* __restrict__ mod_g, int gate_idx, const float* __restrict__ gpost,
                                           bool do_u, const float* __restrict__ mod_u, int shift_idx, int scale_idx, const float* __restrict__ gpre, bf16_t* __restrict__ u, int lane, int wave) {
    const int gw = blockIdx.x * 8 + wave, NGW = gridDim.x * 8, nlatch = NLAT >> 4, nitems = nlatch + (nrows - NLAT);
    for (int ch = gw; ch < nitems; ch += NGW) {
        const bool single = ch >= nlatch;
        const int row0 = single ? NLAT + (ch - nlatch) : ch * 16, set = row0 < NLAT ? row0 / SEQ : 4;
        f32x4 gg[4], pa[4], pb[4];
#pragma unroll
        for (int j = 0; j < 4; ++j) { const int col = 4 * lane + 256 * j;
            if (y) gg[j] = *(const f32x4*)(mod_g + (size_t)set * NMODC + gate_idx * DM + col) * *(const f32x4*)(gpost + col) * rs;
            if (do_u) { pa[j] = *(const f32x4*)(gpre + col) * (*(const f32x4*)(mod_u + (size_t)set * NMODC + scale_idx * DM + col) + 1.f); pb[j] = *(const f32x4*)(mod_u + (size_t)set * NMODC + shift_idx * DM + col); } }
#pragma unroll 1
        for (int g = 0; g < (single ? 6 : 16); g += 6) {
            u32x2 hw[6][4]; u32x2 yw[6][4];
#pragma unroll
            for (int q = 0; q < 6; ++q) { if ((single && q > 0) || g + q >= 16) continue;
                const int row = single ? row0 : row0 + g + q;
#pragma unroll
                for (int j = 0; j < 4; ++j) hw[q][j] = *(const u32x2*)(hb + (size_t)row * DM + 4 * lane + 256 * j);
                if (y && !(single && ypart)) {
#pragma unroll
                    for (int j = 0; j < 4; ++j) yw[q][j] = *(const u32x2*)(y + (size_t)row * DM + 4 * lane + 256 * j);
                } }
#pragma unroll
            for (int q = 0; q < 6; ++q) { if ((single && q > 0) || g + q >= 16) continue;
                const int row = single ? row0 : row0 + g + q;
                f32x4 hv[4];
#pragma unroll
                for (int j = 0; j < 4; ++j) { const u32x2 w = hw[q][j]; hv[j] = (f32x4){bflo(w.x), bfhi(w.x), bflo(w.y), bfhi(w.y)}; }
                if (y) {
                    f32x4 yv[4]; float ss = 0.f;
                    if (single && ypart) {
#pragma unroll
                        for (int j = 0; j < 4; ++j) yv[j] = (f32x4){0.f, 0.f, 0.f, 0.f};
#pragma unroll 1
                        for (int sp0 = 0; sp0 < nsplit; sp0 += 6) {
                            u32x2 t[6][4];
#pragma unroll
                            for (int s4 = 0; s4 < 6; ++s4) { const int sp_ = (sp0 + s4 < nsplit) ? sp0 + s4 : sp0;
#pragma unroll
                                for (int j = 0; j < 4; ++j) t[s4][j] = *(const u32x2*)(ypart + ((size_t)sp_ * NCTX + (row - NLAT)) * DM + 4 * lane + 256 * j); }
#pragma unroll
                            for (int s4 = 0; s4 < 6; ++s4) { if (sp0 + s4 < nsplit) {
#pragma unroll
                                for (int j = 0; j < 4; ++j) yv[j] = yv[j] + (f32x4){bflo(t[s4][j].x), bfhi(t[s4][j].x), bflo(t[s4][j].y), bfhi(t[s4][j].y)}; } }
                        }
                    }
#pragma unroll
                    for (int j = 0; j < 4; ++j) { const u32x2 w = yw[q][j];
                        if (!(single && ypart)) yv[j] = (f32x4){bflo(w.x), bfhi(w.x), bflo(w.y), bfhi(w.y)};
                        ss += (yv[j].x * yv[j].x + yv[j].y * yv[j].y) + (yv[j].z * yv[j].z + yv[j].w * yv[j].w); }
                    const float r = __builtin_amdgcn_rsqf(wave_sum(ss) * (1.f / DM) + RMS_EPS);
#pragma unroll
                    for (int j = 0; j < 4; ++j) { const int col = 4 * lane + 256 * j;
                        hv[j] = hv[j] + (yv[j] * r) * gg[j];
                        if (out_f32) *(f32x4*)(out_f32 + (size_t)row * DM + col) = hv[j];
                        else { u32x2 w; w.x = pk2(hv[j].x, hv[j].y); w.y = pk2(hv[j].z, hv[j].w); *(u32x2*)(hb + (size_t)row * DM + col) = w;
                               hv[j] = (f32x4){bflo(w.x), bfhi(w.x), bflo(w.y), bfhi(w.y)}; } }
                }
                if (do_u) {
                    float ss = 0.f;
#pragma unroll
                    for (int j = 0; j < 4; ++j) ss += (hv[j].x * hv[j].x + hv[j].y * hv[j].y) + (hv[j].z * hv[j].z + hv[j].w * hv[j].w);
                    const float r = __builtin_amdgcn_rsqf(wave_sum(ss) * (1.f / DM) + RMS_EPS);
#pragma unroll
                    for (int j = 0; j < 4; ++j) { const int col = 4 * lane + 256 * j;
                        const f32x4 o = (hv[j] * r) * pa[j] + pb[j];
                        u32x2 w; w.x = pk2(o.x, o.y); w.y = pk2(o.z, o.w); *(u32x2*)(u + (size_t)row * DM + col) = w; }
                }
            }
        }
    }
}

typedef unsigned long long u64_t;
__device__ __forceinline__ bf16x8 gld16(const bf16_t* p) { return *(const bf16x8*)p; }
__device__ __forceinline__ bf16x8 gld8x2(const bf16_t* p0, const bf16_t* p1) { const u32x2 a = *(const u32x2*)p0, b = *(const u32x2*)p1; u32x4 w; w.x = a.x; w.y = a.y; w.z = b.x; w.w = b.y; return __builtin_bit_cast(bf16x8, w); }
__device__ __forceinline__ float max4q(float v) { v = fmaxf(v, __shfl_xor(v, 16)); v = fmaxf(v, __shfl_xor(v, 32)); return v; }
__device__ __forceinline__ float sum4q(float v) { v += __shfl_xor(v, 16); v += __shfl_xor(v, 32); return v; }
constexpr int AT_STAGE = 16384;
__device__ __forceinline__ void attn_unit(LAS unsigned char* lds, int uid, const bf16_t* __restrict__ proj, const bf16_t* __restrict__ vt, bf16_t* __restrict__ mix, const float* sinkp, int tid, int lane, int wave) {
    constexpr float L2E = 1.4426950408889634f;
    const bool isctx = uid >= 1024;
    int b, kvh, nb, hp;
    if (!isctx) { hp = (uid >> 3) & 1; const int r_ = ((uid >> 4) << 3) | (uid & 7); kvh = r_ & 1; nb = (r_ >> 1) & 63; b = r_ >> 7; }
    else { const int c = uid - 1024; hp = c & 1; kvh = (c >> 1) & 1; nb = (c >> 2) & 1; b = c >> 3; }
    const int qrow0 = isctx ? NLAT + b * CTXL + nb * 128 : b * SEQ + nb * 128;
    const int qpos0 = nb * 128;
    const int fr = lane & 15, fq = lane >> 4;
    const int h = kvh * 4 + hp * 2 + (wave >> 2);
    const int qi0 = (wave & 3) * 32;
    const float sink2 = sinkp[h] * L2E;
    bf16x8 qf[2][2];
#pragma unroll
    for (int rt = 0; rt < 2; ++rt)
#pragma unroll
        for (int kc = 0; kc < 2; ++kc) qf[rt][kc] = gld16(proj + (size_t)(qrow0 + qi0 + rt * 16 + fr) * INW + C_QA + h * 64 + kc * 32 + fq * 8);
    float m2[2], lsum[2]; f32x4 O[2][4];
#pragma unroll
    for (int rt = 0; rt < 2; ++rt) { m2[rt] = sink2; lsum[rt] = (fq == 0) ? 1.f : 0.f;
#pragma unroll
        for (int dt = 0; dt < 4; ++dt) O[rt][dt] = (f32x4){0.f, 0.f, 0.f, 0.f}; }
    const int tb0 = isctx ? 0 : (nb == 0 ? 2 : 0), tb1 = isctx ? 0 : (nb == 63 ? 4 : 6), nband = tb1 - tb0, ntile = nband + 4;
    const int srow = tid >> 3, sch = tid & 7;
    const bf16_t* kg = proj + C_KA + kvh * 64 + sch * 8 + (size_t)srow * INW;
    const bf16_t* vg = vt + (size_t)(kvh * 64 + srow) * TROWS + sch * 8;
    const int sto = srow * 128 + ((sch ^ (srow & 7)) << 4);
    const int kr0 = (fr >> 2) * 8 + (fr & 3);
    const int ko00 = kr0 * 128 + (((fq) ^ (kr0 & 7)) << 4), ko01 = kr0 * 128 + (((4 + fq) ^ (kr0 & 7)) << 4);
    const int ko10 = (kr0 + 4) * 128 + (((fq) ^ ((kr0 + 4) & 7)) << 4), ko11 = (kr0 + 4) * 128 + (((4 + fq) ^ ((kr0 + 4) & 7)) << 4);
    const int vo0 = 8192 + fr * 128 + (((fq) ^ (fr & 7)) << 4), vo1 = 8192 + fr * 128 + (((4 + fq) ^ (fr & 7)) << 4);
#define AT_KROW(jj) (((jj) < nband) ? b * SEQ + (nb - 1) * 128 + (tb0 + (jj)) * 64 : NLAT + b * CTXL + ((jj) - nband) * 64)
    __syncthreads();
    u32x4 kreg, vreg;
    { const int kr = AT_KROW(0); kreg = *(const u32x4*)(kg + (size_t)kr * INW); vreg = *(const u32x4*)(vg + kr); }
    lds_st16(lds, sto, kreg); lds_st16(lds, 8192 + sto, vreg);
    if (ntile > 1) { const int kr = AT_KROW(1); kreg = *(const u32x4*)(kg + (size_t)kr * INW); vreg = *(const u32x4*)(vg + kr); }
    __syncthreads();
#pragma unroll 1
    for (int j = 0; j < ntile; ++j) {
        const bool band = j < nband;
        const int kp0 = (nb - 1) * 128 + (tb0 + j) * 64;
        LAS unsigned char* st = lds + (j & 1) * AT_STAGE;
        if (j + 1 < ntile) { LAS unsigned char* sn = lds + ((j + 1) & 1) * AT_STAGE; lds_st16(sn, sto, kreg); lds_st16(sn, 8192 + sto, vreg); }
        if (j + 2 < ntile) { const int kr = AT_KROW(j + 2); kreg = *(const u32x4*)(kg + (size_t)kr * INW); vreg = *(const u32x4*)(vg + kr); }
        f32x4 s[2][4];
#pragma unroll
        for (int pi = 0; pi < 2; ++pi) {
            const bf16x8 k00 = lds_ld16(st, pi * 4096 + ko00), k01 = lds_ld16(st, pi * 4096 + ko01), k10 = lds_ld16(st, pi * 4096 + ko10), k11 = lds_ld16(st, pi * 4096 + ko11);
#pragma unroll
            for (int rt = 0; rt < 2; ++rt) {
                s[rt][2 * pi] = mfma16(k00, qf[rt][0], (f32x4){0.f, 0.f, 0.f, 0.f}); s[rt][2 * pi] = mfma16(k01, qf[rt][1], s[rt][2 * pi]);
                s[rt][2 * pi + 1] = mfma16(k10, qf[rt][0], (f32x4){0.f, 0.f, 0.f, 0.f}); s[rt][2 * pi + 1] = mfma16(k11, qf[rt][1], s[rt][2 * pi + 1]); }
        }
        bf16x8 vf[4][2];
#pragma unroll
        for (int dt = 0; dt < 4; ++dt) { vf[dt][0] = lds_ld16(st, dt * 2048 + vo0); vf[dt][1] = lds_ld16(st, dt * 2048 + vo1); }
#pragma unroll
        for (int rt = 0; rt < 2; ++rt) {
            const int qlo = qpos0 + qi0 + rt * 16;
            if (band && (kp0 + 63 - qlo > 128 || qlo + 15 - kp0 > 128)) {
                const int dbase = (kp0 + fq * 8) - (qlo + fr);
#pragma unroll
                for (int n = 0; n < 4; ++n)
#pragma unroll
                    for (int r = 0; r < 4; ++r) { const int d = dbase + (n >> 1) * 32 + (n & 1) * 4 + r; if (d > 128 || d < -128) s[rt][n][r] = -1e30f; }
            }
            float mx = fmaxf(fmaxf(fmaxf(s[rt][0][0], s[rt][0][1]), fmaxf(s[rt][0][2], s[rt][0][3])), fmaxf(fmaxf(s[rt][1][0], s[rt][1][1]), fmaxf(s[rt][1][2], s[rt][1][3])));
            mx = fmaxf(mx, fmaxf(fmaxf(fmaxf(s[rt][2][0], s[rt][2][1]), fmaxf(s[rt][2][2], s[rt][2][3])), fmaxf(fmaxf(s[rt][3][0], s[rt][3][1]), fmaxf(s[rt][3][2], s[rt][3][3]))));
            mx = max4q(mx);
            const float mn = fmaxf(m2[rt], mx * L2E), alpha = __builtin_amdgcn_exp2f(m2[rt] - mn); m2[rt] = mn;
            float ps = 0.f;
#pragma unroll
            for (int n = 0; n < 4; ++n)
#pragma unroll
                for (int r = 0; r < 4; ++r) { const float pv = __builtin_amdgcn_exp2f(__builtin_fmaf(s[rt][n][r], L2E, -mn)); s[rt][n][r] = pv; ps += pv; }
            lsum[rt] = lsum[rt] * alpha + ps;
#pragma unroll
            for (int dt = 0; dt < 4; ++dt) O[rt][dt] = O[rt][dt] * alpha;
#pragma unroll
            for (int pi = 0; pi < 2; ++pi) { u32x4 w; w.x = pk2(s[rt][2 * pi][0], s[rt][2 * pi][1]); w.y = pk2(s[rt][2 * pi][2], s[rt][2 * pi][3]); w.z = pk2(s[rt][2 * pi + 1][0], s[rt][2 * pi + 1][1]); w.w = pk2(s[rt][2 * pi + 1][2], s[rt][2 * pi + 1][3]);
                const bf16x8 pb = __builtin_bit_cast(bf16x8, w);
#pragma unroll
                for (int dt = 0; dt < 4; ++dt) O[rt][dt] = mfma16(vf[dt][pi], pb, O[rt][dt]); }
        }
        __syncthreads();
    }
#undef AT_KROW
#pragma unroll
    for (int rt = 0; rt < 2; ++rt) { const float inv = 1.f / sum4q(lsum[rt]);
        bf16_t* op = mix + (size_t)(qrow0 + qi0 + rt * 16 + fr) * DM + h * 64 + fq * 4;
#pragma unroll
        for (int dt = 0; dt < 4; ++dt) { u32x2 w; w.x = pk2(O[rt][dt][0] * inv, O[rt][dt][1] * inv); w.y = pk2(O[rt][dt][2] * inv, O[rt][dt][3] * inv); *(u32x2*)(op + dt * 16) = w; } }
}

__device__ __forceinline__ bf16x8 scale_frag8(bf16x8 a, float base, const float (&pj)[8]) {
    const u32x4 u = __builtin_bit_cast(u32x4, a); f32x8 f = unpack8(u);
#pragma unroll
    for (int i = 0; i < 8; ++i) f[i] *= base * pj[i];
    return __builtin_bit_cast(bf16x8, pack8(f));
}
struct KvRegs { u32x4 v[4], k[2]; };
__device__ __forceinline__ void kv_load(KvRegs& R, int uid, const bf16_t* __restrict__ vt, const bf16_t* __restrict__ kt, int tid) {
    const int sqc = uid >> 2, h = uid & 3, row0 = sqc * 128;
#pragma unroll
    for (int k = 0; k < 4; ++k) { const int i = tid + 512 * k, e = i >> 4, c = i & 15; R.v[k] = *(const u32x4*)(vt + (size_t)(128 + h * 128 + e) * TROWS + row0 + c * 8); }
#pragma unroll
    for (int k = 0; k < 2; ++k) { const int i = tid + 512 * k, d = i >> 4, c = i & 15; R.k[k] = *(const u32x4*)(kt + (size_t)(h * 64 + d) * TROWS + row0 + c * 8); }
}
__device__ __forceinline__ void kv_store(const KvRegs& R, LAS unsigned char* lds, int tid) {
#pragma unroll
    for (int k = 0; k < 4; ++k) { const int i = tid + 512 * k, e = i >> 4, c = i & 15; lds_st16(lds, e * 256 + ((c ^ (e & 7)) << 4), R.v[k]); }
#pragma unroll
    for (int k = 0; k < 2; ++k) { const int i = tid + 512 * k, d = i >> 4, c = i & 15; lds_st16(lds, 32768 + d * 256 + ((c ^ (d & 7)) << 4), R.k[k]); }
}
__device__ __forceinline__ void kv_compute(LAS unsigned char* lds, int uid, bf16_t* __restrict__ kvbuf, const float* dfp, const float* dbp, int lane, int wave) {
    const int sqc = uid >> 2, h = uid & 3;
    const float lf = logsig(dfp[h]), lb = logsig(dbp[h]);
    const int fr = lane & 15, fq = lane >> 4, e0 = wave * 16;
    float pjf[8], pjb[8];
#pragma unroll
    for (int i = 0; i < 8; ++i) { pjf[i] = __expf(-(float)i * lf); pjb[i] = __expf((float)i * lb); }
    const int vo0 = fr * 256 + (((fq) ^ (fr & 7)) << 4), vo1 = fr * 256 + (((4 + fq) ^ (fr & 7)) << 4);
    f32x4 af[4], ab[4];
#pragma unroll
    for (int dt = 0; dt < 4; ++dt) { af[dt] = (f32x4){0.f, 0.f, 0.f, 0.f}; ab[dt] = (f32x4){0.f, 0.f, 0.f, 0.f}; }
#pragma unroll
    for (int ks = 0; ks < 4; ++ks) { const int vo = ((ks & 1) ? vo1 : vo0) + (ks >> 1) * 128;
        const bf16x8 a = lds_ld16(lds, e0 * 256 + vo);
        const int s0 = ks * 32 + fq * 8;
        const bf16x8 a_f = scale_frag8(a, __expf((float)(127 - s0) * lf), pjf), a_b = scale_frag8(a, __expf((float)s0 * lb), pjb);
#pragma unroll
        for (int dt = 0; dt < 4; ++dt) { const bf16x8 kb = lds_ld16(lds, 32768 + dt * 4096 + vo); af[dt] = mfma16(a_f, kb, af[dt]); ab[dt] = mfma16(a_b, kb, ab[dt]); } }
    bf16_t* of = kvbuf + ((size_t)sqc * 4 + h) * 8192, *ob = kvbuf + ((size_t)(NCH + sqc) * 4 + h) * 8192;
#pragma unroll
    for (int dt = 0; dt < 4; ++dt)
#pragma unroll
        for (int r = 0; r < 4; ++r) { of[(e0 + fq * 4 + r) * 64 + dt * 16 + fr] = (bf16_t)f2bf(af[dt][r]); ob[(e0 + fq * 4 + r) * 64 + dt * 16 + fr] = (bf16_t)f2bf(ab[dt][r]); }
}
__device__ __forceinline__ void kv_phase(LAS unsigned char* lds, int ufirst, int nunits, const bf16_t* __restrict__ vt, const bf16_t* __restrict__ kt, bf16_t* __restrict__ kvbuf, const float* dfp, const float* dbp, int tid, int lane, int wave) {
    int u = ufirst;
    if (u >= nunits) return;
    KvRegs R; kv_load(R, u, vt, kt, tid);
    for (; u < nunits; u += gridDim.x) {
        __syncthreads();
        kv_store(R, lds, tid);
        __syncthreads();
        const int un = u + gridDim.x;
        if (un < nunits) kv_load(R, un, vt, kt, tid);
        kv_compute(lds, u, kvbuf, dfp, dbp, lane, wave);
    }
    __syncthreads();
}

__device__ __forceinline__ void scan_phase(const bf16_t* __restrict__ kv, bf16_t* __restrict__ sp, const float* dfp, const float* dbp, bool ctx_out, int tid) {
    const int gt = blockIdx.x * NTHREADS + tid, NT = gridDim.x * NTHREADS;
    for (int idx = gt; idx < 2 * 4 * 4 * 2048; idx += NT) {
        const int elem = (idx & 2047) * 4, h = (idx >> 11) & 3, b = (idx >> 13) & 3, dir = idx >> 15;
        const float G = __expf(128.f * logsig(dir ? dbp[h] : dfp[h]));
        const bf16_t* base = kv + (size_t)dir * NCH * 4 * 8192 + (size_t)h * 8192 + elem;
        bf16_t* spb = sp + (size_t)dir * NCH * 4 * 8192 + (size_t)h * 8192 + elem;
        const size_t CS = 4 * 8192;
        const u32x2 c0 = *(const u32x2*)(base + (size_t)(256 + b * 2) * CS), c1 = *(const u32x2*)(base + (size_t)(256 + b * 2 + 1) * CS);
        float S0, S1, S2, S3;
        if (dir == 0) { S0 = G * bflo(c0.x) + bflo(c1.x); S1 = G * bfhi(c0.x) + bfhi(c1.x); S2 = G * bflo(c0.y) + bflo(c1.y); S3 = G * bfhi(c0.y) + bfhi(c1.y); }
        else { S0 = bflo(c0.x) + G * bflo(c1.x); S1 = bfhi(c0.x) + G * bfhi(c1.x); S2 = bflo(c0.y) + G * bflo(c1.y); S3 = bfhi(c0.y) + G * bfhi(c1.y); }
        const int nstart = dir == 0 ? 0 : 63, nstep = dir == 0 ? 1 : -1;
#pragma unroll 1
        for (int nb = 0; nb < 64; nb += 32) {
            u32x2 v[32];
#pragma unroll
            for (int j = 0; j < 32; ++j) v[j] = *(const u32x2*)(base + (size_t)(b * 64 + nstart + nstep * (nb + j)) * CS);
#pragma unroll
            for (int j = 0; j < 32; ++j) { u32x2 w; w.x = pk2(S0, S1); w.y = pk2(S2, S3); *(u32x2*)(spb + (size_t)(b * 64 + nstart + nstep * (nb + j)) * CS) = w;
                S0 = G * S0 + bflo(v[j].x); S1 = G * S1 + bfhi(v[j].x); S2 = G * S2 + bflo(v[j].y); S3 = G * S3 + bfhi(v[j].y); }
        }
        if (ctx_out) {
            const u32x2 z = (u32x2){0u, 0u};
            if (dir == 0) { *(u32x2*)(spb + (size_t)(256 + b * 2) * CS) = z; *(u32x2*)(spb + (size_t)(256 + b * 2 + 1) * CS) = c0; }
            else { *(u32x2*)(spb + (size_t)(256 + b * 2 + 1) * CS) = z; *(u32x2*)(spb + (size_t)(256 + b * 2) * CS) = c1; }
        }
    }
}

__device__ __forceinline__ bf16x8 scale_frag(bf16x8 a, float sc) {
    const u32x4 u = __builtin_bit_cast(u32x4, a); f32x8 f = unpack8(u);
#pragma unroll
    for (int i = 0; i < 8; ++i) f[i] *= sc;
    return __builtin_bit_cast(bf16x8, pack8(f));
}
constexpr int RO_KS = 0, RO_VS = 16384, RO_SF = 49152, RO_SB = 65536;
struct RoRegs { u32x4 k[2], v[4], f[2], b[2]; };
__device__ __forceinline__ void ro_load(RoRegs& R, int uid, const bf16_t* __restrict__ proj, const bf16_t* __restrict__ vt, const bf16_t* __restrict__ sp, int tid) {
    const int sqc = uid >> 2, h = uid & 3, row0 = sqc * 128;
#pragma unroll
    for (int k = 0; k < 2; ++k) { const int i = tid + 512 * k, r = i >> 3, c = i & 7;
        R.k[k] = *(const u32x4*)(proj + (size_t)(row0 + r) * INW + C_KR + h * 64 + c * 8);
        R.f[k] = *(const u32x4*)(sp + ((size_t)sqc * 4 + h) * 8192 + r * 64 + c * 8);
        R.b[k] = *(const u32x4*)(sp + ((size_t)(NCH + sqc) * 4 + h) * 8192 + r * 64 + c * 8); }
#pragma unroll
    for (int k = 0; k < 4; ++k) { const int i = tid + 512 * k, e = i >> 4, c = i & 15;
        R.v[k] = *(const u32x4*)(vt + (size_t)(128 + h * 128 + e) * TROWS + row0 + c * 8); }
}
__device__ __forceinline__ void ro_store(const RoRegs& R, LAS unsigned char* lds, int tid) {
#pragma unroll
    for (int k = 0; k < 2; ++k) { const int i = tid + 512 * k, r = i >> 3, c = i & 7, o = r * 128 + ((c ^ (r & 7)) << 4);
        lds_st16(lds, RO_KS + o, R.k[k]); lds_st16(lds, RO_SF + o, R.f[k]); lds_st16(lds, RO_SB + o, R.b[k]); }
#pragma unroll
    for (int k = 0; k < 4; ++k) { const int i = tid + 512 * k, e = i >> 4, c = i & 15;
        lds_st16(lds, RO_VS + e * 256 + ((c ^ (e & 7)) << 4), R.v[k]); }
}
__device__ __forceinline__ void retout_compute(LAS unsigned char* lds, int uid, const bf16_t* __restrict__ proj, bf16_t* __restrict__ mix, const float* dfp, const float* dbp, const float* gnp, int lane, int wave) {
    const int sqc = uid >> 2, h = uid & 3;
    const int row0 = sqc * 128;
    const float l2f = logsig(dfp[h]) * 1.4426950408889634f, l2b = logsig(dbp[h]) * 1.4426950408889634f;
    const int fr = lane & 15, fq = lane >> 4, q0 = wave * 16;
    const size_t qrow = (size_t)(row0 + q0 + fr);
    const bf16_t* qp = proj + qrow * INW + C_QR + h * 64 + fq * 8;
    const bf16x8 aq0 = gld16(qp), aq1 = gld16(qp + 32);
    u32x2 gw[8];
#pragma unroll
    for (int et = 0; et < 8; ++et) gw[et] = *(const u32x2*)(proj + qrow * INW + C_GR + h * 128 + et * 16 + fq * 4);
    const int kr0 = (fr >> 2) * 8 + (fr & 3);
    const int ko00 = kr0 * 128 + (((fq) ^ (kr0 & 7)) << 4), ko01 = kr0 * 128 + (((4 + fq) ^ (kr0 & 7)) << 4);
    const int ko10 = (kr0 + 4) * 128 + (((fq) ^ ((kr0 + 4) & 7)) << 4), ko11 = (kr0 + 4) * 128 + (((4 + fq) ^ ((kr0 + 4) & 7)) << 4);
    const int fo0 = fr * 128 + (((fq) ^ (fr & 7)) << 4), fo1 = fr * 128 + (((4 + fq) ^ (fr & 7)) << 4);
    const int vo0 = fr * 256 + (((fq) ^ (fr & 7)) << 4), vo1 = fr * 256 + (((4 + fq) ^ (fr & 7)) << 4);
    bf16x8 wb[4];
#pragma unroll
    for (int pi = 0; pi < 4; ++pi) {
        f32x4 s0 = mfma16(lds_ld16(lds, RO_KS + pi * 4096 + ko00), aq0, (f32x4){0.f, 0.f, 0.f, 0.f}); s0 = mfma16(lds_ld16(lds, RO_KS + pi * 4096 + ko01), aq1, s0);
        f32x4 s1 = mfma16(lds_ld16(lds, RO_KS + pi * 4096 + ko10), aq0, (f32x4){0.f, 0.f, 0.f, 0.f}); s1 = mfma16(lds_ld16(lds, RO_KS + pi * 4096 + ko11), aq1, s1);
        const int d0 = (q0 + fr) - (pi * 32 + fq * 8);
#pragma unroll
        for (int r = 0; r < 4; ++r) { const int da = d0 - r, db = d0 - 4 - r;
            s0[r] *= da >= 0 ? __builtin_amdgcn_exp2f((float)da * l2f) : __builtin_amdgcn_exp2f((float)(-da) * l2b);
            s1[r] *= db >= 0 ? __builtin_amdgcn_exp2f((float)db * l2f) : __builtin_amdgcn_exp2f((float)(-db) * l2b); }
        u32x4 w; w.x = pk2(s0[0], s0[1]); w.y = pk2(s0[2], s0[3]); w.z = pk2(s1[0], s1[1]); w.w = pk2(s1[2], s1[3]);
        wb[pi] = __builtin_bit_cast(bf16x8, w);
    }
    const float xf = __builtin_amdgcn_exp2f((float)(q0 + fr + 1) * l2f), xb = __builtin_amdgcn_exp2f((float)(128 - (q0 + fr)) * l2b);
    const bf16x8 qsf0 = scale_frag(aq0, xf), qsf1 = scale_frag(aq1, xf), qsb0 = scale_frag(aq0, xb), qsb1 = scale_frag(aq1, xb);
    f32x4 o[8];
#pragma unroll
    for (int et = 0; et < 8; ++et) {
        f32x4 acc = mfma16(lds_ld16(lds, RO_VS + et * 4096 + vo0), wb[0], (f32x4){0.f, 0.f, 0.f, 0.f});
        acc = mfma16(lds_ld16(lds, RO_VS + et * 4096 + vo1), wb[1], acc);
        acc = mfma16(lds_ld16(lds, RO_VS + et * 4096 + 128 + vo0), wb[2], acc);
        acc = mfma16(lds_ld16(lds, RO_VS + et * 4096 + 128 + vo1), wb[3], acc);
        acc = mfma16(lds_ld16(lds, RO_SF + et * 2048 + fo0), qsf0, acc); acc = mfma16(lds_ld16(lds, RO_SF + et * 2048 + fo1), qsf1, acc);
        acc = mfma16(lds_ld16(lds, RO_SB + et * 2048 + fo0), qsb0, acc); acc = mfma16(lds_ld16(lds, RO_SB + et * 2048 + fo1), qsb1, acc);
        o[et] = acc;
    }
    float sm = 0.f;
#pragma unroll
    for (int et = 0; et < 8; ++et) sm += (o[et][0] + o[et][1]) + (o[et][2] + o[et][3]);
    const float mu = sum4q(sm) * (1.f / 128.f);
    float vs = 0.f;
#pragma unroll
    for (int et = 0; et < 8; ++et)
#pragma unroll
        for (int r = 0; r < 4; ++r) { const float dd = o[et][r] - mu; vs += dd * dd; }
    const float rstd = __builtin_amdgcn_rsqf(sum4q(vs) * (1.f / 128.f) + GN_EPS);
    bf16_t* mp = mix + qrow * DM + 512 + h * 128 + fq * 4; const float* gg = gnp + h * 128 + fq * 4;
#pragma unroll
    for (int et = 0; et < 8; ++et) { const f32x4 gn = *(const f32x4*)(gg + et * 16);
        const float g0 = bflo(gw[et].x), g1 = bfhi(gw[et].x), g2 = bflo(gw[et].y), g3 = bfhi(gw[et].y);
        u32x2 w; w.x = pk2((o[et][0] - mu) * rstd * gn[0] * silu_f(g0), (o[et][1] - mu) * rstd * gn[1] * silu_f(g1));
        w.y = pk2((o[et][2] - mu) * rstd * gn[2] * silu_f(g2), (o[et][3] - mu) * rstd * gn[3] * silu_f(g3));
        *(u32x2*)(mp + et * 16) = w; }
}
__device__ __forceinline__ void retout_phase(LAS unsigned char* lds, int nunits, const bf16_t* __restrict__ proj, const bf16_t* __restrict__ vt, bf16_t* __restrict__ mix, const bf16_t* __restrict__ sp,
                                             const float* dfp, const float* dbp, const float* gnp, int tid, int lane, int wave) {
    int u = blockIdx.x;
    if (u >= nunits) return;
    RoRegs R; ro_load(R, u, proj, vt, sp, tid);
    for (; u < nunits; u += gridDim.x) {
        __syncthreads();
        ro_store(R, lds, tid);
        __syncthreads();
        const int un = u + gridDim.x;
        if (un < nunits) ro_load(R, un, proj, vt, sp, tid);
        retout_compute(lds, u, proj, mix, dfp, dbp, gnp, lane, wave);
    }
}

#define XB_TMO      128
#define XB_XCNT(j)  (256  + 64 * (j))
#define XB_XSUB(j)  (1280 + 64 * (j))
#define XB_XGEN(j)  (2304 + 64 * (j))
#define XB_TOP      3328
#define XB_TOPGEN   3392
#define XCD_BAR_WORDS 3456
#define XB_SPIN_CAP (1u << 22)
__device__ __forceinline__ unsigned xb_ld(unsigned* p)              { return __hip_atomic_load(p, __ATOMIC_RELAXED, __HIP_MEMORY_SCOPE_AGENT); }
__device__ __forceinline__ unsigned xb_add(unsigned* p, unsigned v) { return __hip_atomic_fetch_add(p, v, __ATOMIC_RELAXED, __HIP_MEMORY_SCOPE_AGENT); }
__device__ __forceinline__ unsigned xb_xcc_id() { return (unsigned)__builtin_amdgcn_s_getreg((3 << 11) | 20) & 0xFu; }
#define XB_SPIN(cond, bar) do { unsigned _sp = 0; while (cond) { \
    if ((++_sp & 255u) == 0u) { if (xb_ld(&(bar)[XB_TMO])) break; if (_sp > XB_SPIN_CAP) { atomicAdd(&(bar)[XB_TMO], 1u); break; } } } } while (0)
struct XcdBarrier { unsigned* bar; unsigned x; volatile LAS unsigned* st; };
__device__ __forceinline__ XcdBarrier xcd_barrier_post(unsigned* bar, volatile LAS unsigned* st) {
    XcdBarrier b; b.bar = bar; b.x = xb_xcc_id(); b.st = st;
    if (threadIdx.x == 0) (void)xb_add(&bar[XB_XCNT(b.x)], 1u);
    return b;
}
__device__ __forceinline__ void xcd_barrier_complete(unsigned* bar, unsigned x, unsigned& nloc, unsigned& nx) {
    const unsigned G = gridDim.x * gridDim.y * gridDim.z;
    unsigned sum, cnt, mine, sp = 0u;
    for (;;) {
        sum = 0u; cnt = 0u; mine = 0u;
#pragma unroll
        for (unsigned j = 0; j < 16; ++j) { const unsigned c = xb_ld(&bar[XB_XCNT(j)]); sum += c; cnt += (c > 0u) ? 1u : 0u; mine = (j == x) ? c : mine; }
        if (sum == G) break;
        __builtin_amdgcn_s_sleep(1);
        if ((++sp & 255u) == 0u) { if (xb_ld(&bar[XB_TMO])) break; if (sp > XB_SPIN_CAP) { atomicAdd(&bar[XB_TMO], 1u); break; } }
    }
    nloc = mine > 0u ? mine : 1u; nx = cnt > 0u ? cnt : 1u;
}
__device__ __forceinline__ void xcd_barrier(const XcdBarrier& b) {
    asm volatile("s_waitcnt vmcnt(0)" ::: "memory");
    __syncthreads();
    if (threadIdx.x == 0) {
        unsigned* bar = b.bar;
        __builtin_amdgcn_s_waitcnt(0);
        unsigned nloc = b.st[0], nx = b.st[1];
        if (nloc == 0u) { xcd_barrier_complete(bar, b.x, nloc, nx); b.st[0] = nloc; b.st[1] = nx; }
        const unsigned old = xb_add(&bar[XB_XSUB(b.x)], 1u);
        const unsigned gen = old / nloc;
        if (old + 1u == (gen + 1u) * nloc) {
            __builtin_amdgcn_fence(__ATOMIC_RELEASE, "agent");
            asm volatile("s_waitcnt vmcnt(0)" ::: "memory");
            const unsigned og = xb_add(&bar[XB_TOP], 1u);
            const unsigned tg = og / nx;
            if (og + 1u == (tg + 1u) * nx) xb_add(&bar[XB_TOPGEN], 1u);
            else XB_SPIN(xb_ld(&bar[XB_TOPGEN]) == tg, bar);
            __builtin_amdgcn_fence(__ATOMIC_ACQUIRE, "agent");
            xb_add(&bar[XB_XGEN(b.x)], 1u);
            asm volatile("s_waitcnt vmcnt(0)" ::: "memory");
        } else {
            XB_SPIN(xb_ld(&bar[XB_XGEN(b.x)]) == gen, bar);
            __builtin_amdgcn_fence(__ATOMIC_ACQUIRE, "agent");
            asm volatile("s_waitcnt vmcnt(0)" ::: "memory");
        }
    }
    __syncthreads();
}


struct AnyOrder {
    pg8::StaticOrder so; int S, pm0, nN, nwg, G, c;
    __device__ __forceinline__ void init_static(int M, int N, int G_, int c_) { so.init(M, N, G_, c_); S = 1; pm0 = 0; nN = 0; nwg = 0; G = G_; c = c_; }
    __device__ __forceinline__ void init_split(int pm0_, int nMt, int nN_, int S_, int G_, int c_) { so.init(0, 0, G_, c_); S = S_; pm0 = pm0_; nN = nN_; nwg = nMt * nN_ * S_; G = G_; c = c_; }
    __device__ __forceinline__ bool next(int i, pg8::Unit& u) const {
        if (S == 1) return so.next(i, u);
        const int L = i * G + c; if (L >= nwg) return false;
        const int t = L / S; u.ks = L - t * S; u.pn = t % nN; u.pm = pm0 + t / nN; return true;
    }
    __device__ __forceinline__ void a_ready(const pg8::Unit&) const {}
    __device__ __forceinline__ void done(const pg8::Unit&) const {}
};
struct EpiAny {
    static constexpr bool PERM = true, AFTER_DRAIN = false;
    bf16_t* O; int ldc; int mode; unsigned char* ws;
    __device__ __forceinline__ void operator()(const f32x4 (&acc)[2][2][4][2], const pg8::Unit& u, int wr, int wc, int fr, int fq) const {
        const int row0 = u.pm * 256 + wr * 64 + fr;
        if (mode == 2) {
            const int col0 = u.pn * 256 + wc * 32 + 8 * fq;
            const bool lat = u.pm < NLAT / 256;
#pragma unroll
            for (int ai = 0; ai < 2; ++ai)
#pragma unroll
                for (int m = 0; m < 4; ++m) { const int row = row0 + ai * 128 + m * 16, pos = row & (SEQ - 1);
                    bf16_t* rowp = O + (size_t)row * INW + col0;
#pragma unroll
                    for (int bj = 0; bj < 2; ++bj) { f32x4 v0 = acc[ai][bj][m][0], v1 = acc[ai][bj][m][1];
                        const int cb = u.pn * 256 + bj * 128 + wc * 32;
                        if (lat && (cb < C_VA || (cb >= C_QR && cb < C_VR))) {
                            const f32x2* cs = (cb < C_VA) ? (const f32x2*)(ws + WS_AX) + (((wc & 1) ? 128 + (pos & 63) : (pos >> 6)) * 16 + 4 * fq) : (const f32x2*)(ws + WS_RET) + ((size_t)pos * 32 + 16 * (wc & 1) + 4 * fq);
                            const f32x4 t01 = *(const f32x4*)cs, t23 = *(const f32x4*)(cs + 2);
                            const float c0 = t01.x, s0 = t01.y, c1 = t01.z, s1 = t01.w, c2 = t23.x, s2 = t23.y, c3 = t23.z, s3 = t23.w;
                            const f32x4 x1 = v0, x2 = v1;
                            v0[0] = x1[0] * c0 - x2[0] * s0; v1[0] = x2[0] * c0 + x1[0] * s0;
                            v0[1] = x1[1] * c1 - x2[1] * s1; v1[1] = x2[1] * c1 + x1[1] * s1;
                            v0[2] = x1[2] * c2 - x2[2] * s2; v1[2] = x2[2] * c2 + x1[2] * s2;
                            v0[3] = x1[3] * c3 - x2[3] * s3; v1[3] = x2[3] * c3 + x1[3] * s3;
                        }
                        const bool isV = (cb >= C_VA && cb < C_QR) || (cb >= C_VR && cb < C_GR), isKr = (cb >= C_KR && cb < C_VR);
                        if (!isV) { u32x4 w; w.x = pk2(v0[0], v0[1]); w.y = pk2(v0[2], v0[3]); w.z = pk2(v1[0], v1[1]); w.w = pk2(v1[2], v1[3]);
                            *(u32x4*)(rowp + bj * 128) = w; }
                        if (isV || isKr) {
                            const unsigned w0 = pk2(v0[0], v0[1]), w1 = pk2(v0[2], v0[3]), w2 = pk2(v1[0], v1[1]), w3 = pk2(v1[2], v1[3]);
                            const bool odd = fr & 1;
                            const unsigned sx = odd ? w0 : w2, sy = odd ? w1 : w3;
                            const unsigned nx = (unsigned)__builtin_amdgcn_update_dpp(0, (int)sx, 0xB1, 0xF, 0xF, true), ny = (unsigned)__builtin_amdgcn_update_dpp(0, (int)sy, 0xB1, 0xF, 0xF, true);
                            const unsigned mx = odd ? w2 : w0, my = odd ? w3 : w1;
                            const unsigned lo_a = odd ? nx : mx, hi_a = odd ? mx : nx, lo_b = odd ? ny : my, hi_b = odd ? my : ny;
                            const unsigned c0 = (lo_a & 0xffffu) | (hi_a << 16), c1 = (lo_a >> 16) | (hi_a & 0xffff0000u), c2 = (lo_b & 0xffffu) | (hi_b << 16), c3 = (lo_b >> 16) | (hi_b & 0xffff0000u);
                            const int f0 = (isV ? (cb >= C_VR ? cb - C_VR + 128 : cb - C_VA) : cb - C_KR) + 8 * fq + (odd ? 4 : 0);
                            bf16_t* tp = (bf16_t*)(ws + (isV ? WS_VT : WS_KT)) + (size_t)f0 * TROWS + (row & ~1);
                            *(unsigned*)tp = c0; *(unsigned*)(tp + TROWS) = c1; *(unsigned*)(tp + 2 * (size_t)TROWS) = c2; *(unsigned*)(tp + 3 * (size_t)TROWS) = c3; }
                    } }
        } else if (mode == 3) {
            const int col0 = u.pn * 256 + wc * 32 + 8 * fq;
            bf16_t* P = (bf16_t*)(ws + WS_PART) + (size_t)u.ks * NCTX * DM;
#pragma unroll
            for (int ai = 0; ai < 2; ++ai)
#pragma unroll
                for (int m = 0; m < 4; ++m) { bf16_t* rowp = P + (size_t)(row0 + ai * 128 + m * 16 - NLAT) * DM + col0;
#pragma unroll
                    for (int bj = 0; bj < 2; ++bj) { const f32x4 v0 = acc[ai][bj][m][0], v1 = acc[ai][bj][m][1];
                        u32x4 w; w.x = pk2(v0[0], v0[1]); w.y = pk2(v0[2], v0[3]); w.z = pk2(v1[0], v1[1]); w.w = pk2(v1[2], v1[3]);
                        *(u32x4*)(rowp + bj * 128) = w; } }
        } else if (mode == 0) {
            const int col0 = u.pn * 256 + wc * 32 + 8 * fq;
#pragma unroll
            for (int ai = 0; ai < 2; ++ai)
#pragma unroll
                for (int m = 0; m < 4; ++m) { bf16_t* rowp = O + (size_t)(row0 + ai * 128 + m * 16) * ldc + col0;
#pragma unroll
                    for (int bj = 0; bj < 2; ++bj) { const f32x4 v0 = acc[ai][bj][m][0], v1 = acc[ai][bj][m][1];
                        u32x4 w; w.x = pk2(v0[0], v0[1]); w.y = pk2(v0[2], v0[3]); w.z = pk2(v1[0], v1[1]); w.w = pk2(v1[2], v1[3]);
                        *(u32x4*)(rowp + bj * 128) = w; } }
        } else {
            const int col0 = u.pn * 128 + wc * 32 + 8 * fq;
#pragma unroll
            for (int ai = 0; ai < 2; ++ai)
#pragma unroll
                for (int m = 0; m < 4; ++m) { bf16_t* rowp = O + (size_t)(row0 + ai * 128 + m * 16) * DFF + col0;
                    const f32x4 a0 = acc[ai][0][m][0], a1 = acc[ai][0][m][1], b0 = acc[ai][1][m][0], b1 = acc[ai][1][m][1];
                    u32x4 w; w.x = pk2(silu_f(a0[0]) * b0[0], silu_f(a0[1]) * b0[1]); w.y = pk2(silu_f(a0[2]) * b0[2], silu_f(a0[3]) * b0[3]);
                    w.z = pk2(silu_f(a1[0]) * b1[0], silu_f(a1[1]) * b1[1]); w.w = pk2(silu_f(a1[2]) * b1[2], silu_f(a1[3]) * b1[3]);
                    *(u32x4*)rowp = w; }
        }
    }
};

__global__ void __launch_bounds__(NTHREADS) fwd_megakernel(Params p) {
    extern __shared__ __attribute__((aligned(16))) unsigned char smem[];
    LAS unsigned char* lds = (LAS unsigned char*)smem;
    cg::grid_group grid = cg::this_grid();
    constexpr int NSTEPS = 2 + 2 * 12;
    {
        int tid0 = threadIdx.x; asm volatile("" : "+v"(tid0));
        if (tid0 == 0) { ((volatile LAS unsigned*)(lds + LDS_BYTES - 64))[0] = 0u; ((volatile LAS unsigned*)(lds + LDS_BYTES - 64))[1] = 0u; }
    }
    const XcdBarrier xbar = xcd_barrier_post((unsigned*)(p.ws + WS_BAR), (volatile LAS unsigned*)(lds + LDS_BYTES - 64));
    {
        int tid0 = threadIdx.x; asm volatile("" : "+v"(tid0));
        p0_phase(p, lds, tid0, tid0 & 63, __builtin_amdgcn_readfirstlane(tid0 >> 6));
        if (p.ws == nullptr) grid.sync();
        xcd_barrier(xbar);
    }
#pragma unroll 1
    for (int st = 1; st < NSTEPS; ++st) {
        int tid = threadIdx.x; asm volatile("" : "+v"(tid));
        const int lane = tid & 63, wave = __builtin_amdgcn_readfirstlane(tid >> 6);
        unsigned char* ws = p.ws;
        const float* mod = (const float*)(ws + WS_MOD);
        const f32x2* rettab = (const f32x2*)(ws + WS_RET);
        const f32x2* axtab = (const f32x2*)(ws + WS_AX);
        bf16_t* hb = (bf16_t*)(ws + WS_H);
        bf16_t* ub = (bf16_t*)(ws + WS_U);
        bf16_t* yb = (bf16_t*)(ws + WS_Y);
        bf16_t* mixb = (bf16_t*)(ws + WS_U);
        bf16_t* actb = (bf16_t*)(ws + WS_ACT);
        bf16_t* projb = actb;
        bf16_t* kvb = (bf16_t*)(ws + WS_KV);
        bf16_t* spb = (bf16_t*)(ws + WS_SP);
        const bf16_t* vtb = (const bf16_t*)(ws + WS_VT); const bf16_t* ktb = (const bf16_t*)(ws + WS_KT);
        const float* npre = p.in[6]; const float* npost = p.in[7];
        {
            const int l = st < 2 ? 0 : (st - 2) / 12, k = st < 2 ? -1 : (st - 2) % 12;
            const bool last = (l == 1);
            const bf16_t* wl = (const bf16_t*)(ws + WS_W + (size_t)l * SZ_WL);
            const float* modl = mod + (size_t)l * 5 * NMODC;
            const int MR = last ? NLAT : TROWS;
            if (k == 0 || k == 1 || k == 3 || k == 7 || k == 9 || k == 10) {
                const bf16_t* A; const bf16_t* B; bf16_t* O; int M, N, K, ldc, mode;
                if (k == 0)      { A = ub;   B = wl + OW_WI1 / 2;  O = actb;  M = TROWS; N = NWI; K = DM;  ldc = DFF; mode = 1; }
                else if (k == 1) { A = actb; B = wl + OW_WO1 / 2;  O = yb;    M = NLAT;  N = DM;  K = DFF; ldc = DM;  mode = 0; }
                else if (k == 3) { A = ub;   B = wl + OW_WIN / 2;  O = projb; M = TROWS; N = INW; K = DM;  ldc = INW; mode = 2; }
                else if (k == 7) { A = mixb; B = wl + OW_WOUT / 2; O = yb;    M = NLAT;  N = DM;  K = DM;  ldc = DM;  mode = 0; }
                else if (k == 9) { A = ub;   B = wl + OW_WI2 / 2;  O = actb;  M = MR;    N = NWI; K = DM;  ldc = DFF; mode = 1; }
                else             { A = actb; B = wl + OW_WO2 / 2;  O = yb;    M = NLAT;  N = DM;  K = DFF; ldc = DM;  mode = 0; }
                {
                    pg8::Gemm g{A, B, M, N, K, K, 0}; AnyOrder S; S.init_static(M, N, (int)gridDim.x, (int)blockIdx.x);
                    EpiAny E{O, ldc, mode, ws};
                    pg8::gemm_phase<EpiAny, AnyOrder, true, true>(lds, g, S, E);
                }
                if ((k == 1 || k == 7 || k == 10) && (k == 1 || !last)) {
                    pg8::Gemm g{A, B, TROWS, N, 256, K, 256}; AnyOrder S; S.init_split(NLAT / 256, NCTX / 256, N / 256, K / 256, (int)gridDim.x, (int)blockIdx.x);
                    EpiAny E{O, ldc, 3, ws};
                    pg8::gemm_phase<EpiAny, AnyOrder, true, true>(lds, g, S, E);
                }
            } else if (k == -1 || k == 2 || k == 8 || k == 11) {
                const bf16_t* y = (k == -1) ? nullptr : yb;
                const bool first = (l == 0 && k <= 2);
                const float* hs_lat = first ? p.in[0] : nullptr; const float* hs_ctx = first ? p.in[2] : nullptr;
                int nrows, gate_idx, post_i, shift_idx, scale_idx, pre_i; float rs; bool do_u = true; const float* mod_u = modl;
                if (k == -1)     { nrows = TROWS; gate_idx = 0; post_i = 0;         rs = 0.f;  shift_idx = 0; scale_idx = 1; pre_i = 0; }
                else if (k == 2) { nrows = TROWS; gate_idx = 2; post_i = l * 3 + 0; rs = 0.5f; shift_idx = 3; scale_idx = 4; pre_i = l * 3 + 1; }
                else if (k == 8) { nrows = MR;    gate_idx = 5; post_i = l * 3 + 1; rs = 1.0f; shift_idx = 6; scale_idx = 7; pre_i = l * 3 + 2; }
                else             { nrows = MR;    gate_idx = 8; post_i = l * 3 + 2; rs = 0.5f; shift_idx = 0; scale_idx = 1; pre_i = last ? 0 : (l + 1) * 3; do_u = !last; mod_u = last ? modl : modl + 5 * NMODC; }
                if (first) norm_phase(nrows, y, (const bf16_t*)(ws + WS_PART), (k == 8) ? 4 : 11, hs_lat, hs_ctx, hb, (last && k == 11) ? p.out : nullptr, rs, modl, gate_idx, npost + post_i * DM, do_u, mod_u, shift_idx, scale_idx, npre + pre_i * DM, ub, lane, wave);
                else norm_phase8(nrows, y, (const bf16_t*)(ws + WS_PART), (k == 8) ? 4 : 11, hs_lat, hs_ctx, hb, (last && k == 11) ? p.out : nullptr, rs, modl, gate_idx, npost + post_i * DM, do_u, mod_u, shift_idx, scale_idx, npre + pre_i * DM, ub, lane, wave);
            } else if (k == 4) {
                const int NA = last ? 1024 : 1056;
                for (int u = blockIdx.x; u < NA; u += gridDim.x) attn_unit(lds, u, projb, vtb, mixb, p.in[14] + l * 8, tid, lane, wave);
                kv_phase(lds, (int)((blockIdx.x + gridDim.x / 2) % gridDim.x), NCH * 4, vtb, ktb, kvb, p.in[15] + l * 4, p.in[16] + l * 4, tid, lane, wave);
            } else if (k == 5) {
                scan_phase(kvb, spb, p.in[15] + l * 4, p.in[16] + l * 4, !last, tid);
            } else {
                const int NR = last ? 1024 : NCH * 4;
                retout_phase(lds, NR, projb, vtb, mixb, spb, p.in[15] + l * 4, p.in[16] + l * 4, p.in[17] + l * 512, tid, lane, wave);
            }
        }
        if (st + 1 < NSTEPS) xcd_barrier(xbar);
    }
}

extern "C" void kernel_launch(void* const* d_in, const int* in_sizes, int n_in, void* d_out, int out_size, void* d_ws, size_t ws_size, hipStream_t stream) {
    static int grid_blocks = 0;
    if (grid_blocks == 0) {
        if (n_in != 18 || ws_size < WS_END) { fprintf(stderr, "kernel_launch: unexpected n_in %d or workspace %zu < %zu\n", n_in, ws_size, (size_t)WS_END); grid_blocks = -1; return; }
        int dev = 0, cus = 0, per_cu = 0;
        hipGetDevice(&dev);
        hipDeviceGetAttribute(&cus, hipDeviceAttributeMultiprocessorCount, dev);
        if (hipFuncSetAttribute((const void*)fwd_megakernel, hipFuncAttributeMaxDynamicSharedMemorySize, LDS_BYTES) != hipSuccess) fprintf(stderr, "kernel_launch: hipFuncSetAttribute failed\n");
        if (hipOccupancyMaxActiveBlocksPerMultiprocessor(&per_cu, (const void*)fwd_megakernel, NTHREADS, LDS_BYTES) != hipSuccess || per_cu < 1) { fprintf(stderr, "kernel_launch: occupancy query gave %d\n", per_cu); per_cu = 1; }
        (void)hipGetLastError();
        grid_blocks = cus * 1;
        if (grid_blocks % 8) grid_blocks -= grid_blocks % 8;
    }
    if (grid_blocks < 0) return;
    if (hipMemsetAsync((char*)d_ws + WS_BAR, 0, XCD_BAR_WORDS * 4, stream) != hipSuccess) { fprintf(stderr, "kernel_launch: hipMemsetAsync of the barrier words failed\n"); return; }
    Params p{};
    for (int i = 0; i < 18; ++i) p.in[i] = (const float*)d_in[i];
    p.out = (float*)d_out; p.ws = (unsigned char*)d_ws;
    void* args[] = {&p};
    hipError_t e = hipLaunchCooperativeKernel((const void*)fwd_megakernel, dim3(grid_blocks), dim3(NTHREADS), args, LDS_BYTES, stream);
    if (e != hipSuccess) fprintf(stderr, "cooperative launch failed: %s (grid %d)\n", hipGetErrorString(e), grid_blocks);
}
```

```cpp
#include <hip/hip_runtime.h>
#include <hip/hip_cooperative_groups.h>
#include <cstdio>
#include <cstdint>
namespace cg = cooperative_groups;
namespace pg8 {
#define PG8_LAS __attribute__((address_space(3)))
typedef unsigned short bf16_t;
typedef short bf16x8 __attribute__((ext_vector_type(8)));
typedef float f32x4 __attribute__((ext_vector_type(4)));
typedef unsigned u32x4 __attribute__((ext_vector_type(4)));
constexpr int BM = 256, BK = 64, HALF = 128, HTB = HALF * BK * 2  , STAGE_BYTES = 8 * HTB, NXCD = 8, WGM = 8;

__host__ __device__ __forceinline__ int lds_byte(int r, int c) { const int st = (r >> 4) * 2 + (c >> 5), rr = r & 15, cc = c & 31, ob = rr * 64 + cc * 2; return st * 1024 + (ob ^ (((ob >> 9) & 1) << 5)); }
__host__ __device__ __forceinline__ void stage_rc(int b, int& R, int& C) { const int st = b / 1024, sb = b % 1024, swz = sb ^ (((sb >> 9) & 1) << 5); R = (st >> 1) * 16 + swz / 64; C = (st & 1) * 32 + (swz % 64) / 2; }
__host__ __device__ __forceinline__ int perm32(int rho) { const int n = rho >> 4, i = rho & 15; return 8 * (i >> 2) + 4 * n + (i & 3); }

struct Unit { int pm, pn, ks; };
struct Gemm { const bf16_t* A; const bf16_t* Bt; int M, N, K, ld, ksplit; };

struct StaticOrder {
    int nM, nN, nwg, G, c;
    __host__ __device__ void init(int M, int N, int G_, int c_) { nM = M / BM; nN = N / BM; nwg = nM * nN; G = G_; c = c_; }
    __host__ __device__ bool next(int i, Unit& u) const {
        const long L = (long)i * G + c; if (L >= nwg) return false;
        int wgid = (int)L; { const int q = nwg / NXCD, r = nwg % NXCD, xcd = wgid % NXCD, off = wgid / NXCD; wgid = (xcd < r ? xcd * (q + 1) : r * (q + 1) + (xcd - r) * q) + off; }
        const int nig = WGM * nN, gid = wgid / nig, fm = gid * WGM, gsz = (nM - fm) < WGM ? (nM - fm) : WGM;
        u.pm = fm + ((wgid % nig) % gsz); u.pn = (wgid % nig) / gsz; u.ks = 0; return true;
    }
    __device__ __forceinline__ void a_ready(const Unit&) const {}
    __device__ __forceinline__ void done(const Unit&) const {}
};

__device__ __forceinline__ unsigned cvt_pk_bf16(float lo, float hi) { unsigned r; asm volatile("v_cvt_pk_bf16_f32 %0, %1, %2" : "=v"(r) : "v"(lo), "v"(hi)); return r; }
template <class Epi, class Sched, bool ALIGN_EPI = false, bool SP2 = false>
__device__ __forceinline__ void gemm_phase(PG8_LAS unsigned char* lds, const Gemm g, const Sched& S, const Epi& E) {
    int tid_ = threadIdx.x; asm volatile("" : "+v"(tid_)); const int tid = tid_, wid = __builtin_amdgcn_readfirstlane(tid >> 6), lane = tid & 63, wr = wid >> 2, wc = wid & 3, fr = lane & 15, fq = lane >> 4;
    const int K = g.K, nt = K / BK, LD = g.ld;
    unsigned voffA[2], voffB[2];
#pragma unroll
    for (int i = 0; i < 2; ++i) { int R, C; stage_rc(tid * 16 + i * 8192, R, C); const int Rb = Epi::PERM ? ((R & ~31) + perm32(R & 31)) : R;
        voffA[i] = (unsigned)(R * LD + C) * 2u; voffB[i] = (unsigned)(Rb * LD + C) * 2u; }
    const size_t kstep = (size_t)(BK * 2);
    const size_t hstep = (size_t)HALF * LD * 2;
    const size_t tstep = 2 * hstep;
    const unsigned ldsw = (unsigned)wid * 1024u;
    const int aoff = lds_byte(wr * 64 + fr, fq * 8), boff = lds_byte(wc * 32 + fr, fq * 8);
#define PG8_SA(b, h) (((b) * 2 + (h)) * HTB)
#define PG8_SB(b, h) ((4 + (b) * 2 + (h)) * HTB)
#define PG8_STAGE(bufoff, gbase, voff) do { _Pragma("unroll") for (int _i = 0; _i < 2; ++_i) \
        __builtin_amdgcn_global_load_lds((const unsigned*)((const char*)(gbase) + (voff)[_i]), (PG8_LAS unsigned*)(lds + (bufoff) + ldsw + _i * 8192), 16, 0, 0); } while (0)
#define PG8_LDA(dst, b, h) do { _Pragma("unroll") for (int m = 0; m < 4; ++m) _Pragma("unroll") for (int k = 0; k < 2; ++k) dst[m][k] = *(const PG8_LAS bf16x8*)(lds + PG8_SA(b, h) + aoff + m * 2048 + k * 1024); } while (0)
#define PG8_LDB(dst, b, h) do { _Pragma("unroll") for (int n = 0; n < 2; ++n) _Pragma("unroll") for (int k = 0; k < 2; ++k) dst[n][k] = *(const PG8_LAS bf16x8*)(lds + PG8_SB(b, h) + boff + n * 2048 + k * 1024); } while (0)
#define PG8_MMA(ai, bj, At, Bt) do { __builtin_amdgcn_s_setprio(1); _Pragma("unroll") for (int m = 0; m < 4; ++m) _Pragma("unroll") for (int n = 0; n < 2; ++n) _Pragma("unroll") for (int k = 0; k < 2; ++k) \
        acc[ai][bj][m][n] = __builtin_amdgcn_mfma_f32_16x16x32_bf16(Bt[n][k], At[m][k], acc[ai][bj][m][n], 0, 0, 0); __builtin_amdgcn_s_setprio(0); } while (0)
#define PG8_WAIT_V(n) asm volatile("s_waitcnt vmcnt(" #n ")" ::: "memory")
#define PG8_WAIT_L(n) asm volatile("s_waitcnt lgkmcnt(" #n ")" ::: "memory")
#define PG8_BAR __builtin_amdgcn_s_barrier()
#define PG8_SCHED __builtin_amdgcn_sched_barrier(0)
    Unit cur, nxt; int ui = 0;
    if (!S.next(0, cur)) return;
    f32x4 acc[2][2][4][2];
#pragma unroll
    for (int a = 0; a < 2; ++a)
#pragma unroll
        for (int b = 0; b < 2; ++b)
#pragma unroll
            for (int m = 0; m < 4; ++m)
#pragma unroll
                for (int n = 0; n < 2; ++n) acc[a][b][m][n] = (f32x4){0.f, 0.f, 0.f, 0.f};
    bf16x8 At[4][2], B0[2][2], B1[2][2];
    const char* cA = (const char*)g.A + (size_t)cur.pm * tstep + (size_t)cur.ks * g.ksplit * 2; const char* cB = (const char*)g.Bt + (size_t)cur.pn * tstep + (size_t)cur.ks * g.ksplit * 2;
    S.a_ready(cur);
    if constexpr (SP2) {
        PG8_STAGE(PG8_SB(0, 0), cB, voffB); PG8_STAGE(PG8_SB(0, 1), cB + hstep, voffB); PG8_STAGE(PG8_SA(0, 0), cA, voffA); PG8_STAGE(PG8_SA(0, 1), cA + hstep, voffA);
        if (wr == 1) PG8_BAR;
        PG8_WAIT_V(2); PG8_BAR;
        PG8_STAGE(PG8_SB(1, 0), cB + kstep, voffB); PG8_STAGE(PG8_SA(1, 0), cA + kstep, voffA); PG8_STAGE(PG8_SB(1, 1), cB + hstep + kstep, voffB);
        PG8_WAIT_V(6); PG8_BAR;
    } else {
        PG8_STAGE(PG8_SB(0, 0), cB, voffB); PG8_STAGE(PG8_SA(0, 0), cA, voffA); PG8_STAGE(PG8_SB(0, 1), cB + hstep, voffB); PG8_STAGE(PG8_SA(0, 1), cA + hstep, voffA);
        if (wr == 1) PG8_BAR;
        PG8_WAIT_V(4); PG8_BAR;
        PG8_STAGE(PG8_SB(1, 0), cB + kstep, voffB); PG8_STAGE(PG8_SA(1, 0), cA + kstep, voffA); PG8_STAGE(PG8_SB(1, 1), cB + hstep + kstep, voffB);
        PG8_WAIT_V(6); PG8_BAR;
    }
    for (;;) {
        const bool has_next = S.next(ui + 1, nxt);
        const char* nA = has_next ? (const char*)g.A + (size_t)nxt.pm * tstep + (size_t)nxt.ks * g.ksplit * 2 : cA; const char* nB = has_next ? (const char*)g.Bt + (size_t)nxt.pn * tstep + (size_t)nxt.ks * g.ksplit * 2 : cB;
        for (int t = 0; t < nt; t += 2) {
            const bool last = (t == nt - 2);
            const char* a1 = cA + (size_t)(t + 1) * kstep;
            const char* a2 = last ? nA : cA + (size_t)(t + 2) * kstep; const char* b2 = last ? nB : cB + (size_t)(t + 2) * kstep;
            const char* a3 = a2 + kstep; const char* b3 = b2 + kstep;
            if (last && has_next) S.a_ready(nxt);
            if constexpr (SP2) {
            PG8_LDB(B0, 0, 0); PG8_LDB(B1, 0, 1); PG8_SCHED; PG8_LDA(At, 0, 0); PG8_STAGE(PG8_SA(1, 1), a1 + hstep, voffA);
            PG8_WAIT_V(8); PG8_WAIT_L(0); PG8_BAR; PG8_MMA(0, 0, At, B0); PG8_MMA(0, 1, At, B1); PG8_BAR; PG8_SCHED;
            PG8_LDA(At, 0, 1); PG8_STAGE(PG8_SB(0, 0), b2, voffB); PG8_STAGE(PG8_SB(0, 1), b2 + hstep, voffB); PG8_STAGE(PG8_SA(0, 0), a2, voffA);
            PG8_WAIT_V(8); PG8_WAIT_L(0); PG8_BAR; PG8_MMA(1, 0, At, B0); PG8_MMA(1, 1, At, B1); PG8_BAR; PG8_SCHED;
            PG8_LDB(B0, 1, 0); PG8_LDB(B1, 1, 1); PG8_SCHED; PG8_LDA(At, 1, 0); PG8_STAGE(PG8_SA(0, 1), a2 + hstep, voffA);
            PG8_WAIT_V(8); PG8_WAIT_L(0); PG8_BAR; PG8_MMA(0, 0, At, B0); PG8_MMA(0, 1, At, B1); PG8_BAR; PG8_SCHED;
            PG8_LDA(At, 1, 1); PG8_STAGE(PG8_SB(1, 0), b3, voffB); PG8_STAGE(PG8_SB(1, 1), b3 + hstep, voffB); PG8_STAGE(PG8_SA(1, 0), a3, voffA);
            PG8_WAIT_V(8); PG8_WAIT_L(0); PG8_BAR; PG8_MMA(1, 0, At, B0); PG8_MMA(1, 1, At, B1); PG8_BAR; PG8_SCHED;
            } else {
            PG8_LDB(B0, 0, 0); PG8_SCHED; PG8_LDA(At, 0, 0); PG8_STAGE(PG8_SA(1, 1), a1 + hstep, voffA);
            PG8_WAIT_L(8); PG8_BAR; PG8_WAIT_L(0); PG8_MMA(0, 0, At, B0); PG8_BAR; PG8_SCHED;
            PG8_LDB(B1, 0, 1); PG8_STAGE(PG8_SB(0, 0), b2, voffB);
            PG8_BAR; PG8_WAIT_L(0); PG8_MMA(0, 1, At, B1); PG8_BAR;
            PG8_LDA(At, 0, 1); PG8_STAGE(PG8_SA(0, 0), a2, voffA);
            PG8_BAR; PG8_WAIT_L(0); PG8_MMA(1, 0, At, B0); PG8_BAR; PG8_SCHED;
            PG8_STAGE(PG8_SB(0, 1), b2 + hstep, voffB);
            PG8_WAIT_V(6); PG8_BAR; PG8_MMA(1, 1, At, B1); PG8_BAR;
            PG8_LDB(B0, 1, 0); PG8_SCHED; PG8_LDA(At, 1, 0); PG8_STAGE(PG8_SA(0, 1), a2 + hstep, voffA);
            PG8_WAIT_L(8); PG8_BAR; PG8_WAIT_L(0); PG8_MMA(0, 0, At, B0); PG8_BAR; PG8_SCHED;
            PG8_LDB(B1, 1, 1); PG8_STAGE(PG8_SB(1, 0), b3, voffB);
            PG8_BAR; PG8_WAIT_L(0); PG8_MMA(0, 1, At, B1); PG8_BAR;
            PG8_LDA(At, 1, 1); PG8_STAGE(PG8_SA(1, 0), a3, voffA);
            PG8_BAR; PG8_WAIT_L(0); PG8_MMA(1, 0, At, B0); PG8_BAR; PG8_SCHED;
            PG8_STAGE(PG8_SB(1, 1), b3 + hstep, voffB);
            PG8_WAIT_V(6); PG8_BAR; PG8_MMA(1, 1, At, B1); PG8_BAR;
            }
        }
        if constexpr (ALIGN_EPI) { if (wr == 0) PG8_BAR; }
        if constexpr (!Epi::AFTER_DRAIN) { E(acc, cur, wr, wc, fr, fq); S.done(cur); }
        if (!has_next) break;
#pragma unroll
        for (int a = 0; a < 2; ++a)
#pragma unroll
            for (int b = 0; b < 2; ++b)
#pragma unroll
                for (int m = 0; m < 4; ++m)
#pragma unroll
                    for (int n = 0; n < 2; ++n) acc[a][b][m][n] = (f32x4){0.f, 0.f, 0.f, 0.f};
        cur = nxt; cA = nA; cB = nB; ++ui;
        if constexpr (ALIGN_EPI) { if (wr == 1) PG8_BAR; }
    }
    PG8_WAIT_V(0);
    if constexpr (!ALIGN_EPI) { if (wr == 0) PG8_BAR; }
    PG8_BAR;
    if constexpr (Epi::AFTER_DRAIN) { E.fused(acc, cur, wr, wc, fr, fq, lds, wid, lane); S.done(cur); }
#undef PG8_SA
#undef PG8_SB
#undef PG8_STAGE
#undef PG8_LDA
#undef PG8_LDB
#undef PG8_MMA
#undef PG8_WAIT_V
#undef PG8_WAIT_L
#undef PG8_BAR
#undef PG8_SCHED
}
}

#define LAS __attribute__((address_space(3)))
using pg8::bf16_t; using pg8::bf16x8; using pg8::f32x4; using pg8::u32x4;
typedef unsigned u32x2 __attribute__((ext_vector_type(2)));
typedef float f32x2 __attribute__((ext_vector_type(2)));
typedef float f32x8 __attribute__((ext_vector_type(8)));

constexpr int DM = 1024, NBATCH = 4, SEQ = 8192, CTXL = 256;
constexpr int NLAT = NBATCH * SEQ, NCTX = NBATCH * CTXL, TROWS = NLAT + NCTX;
constexpr int DFF = 2816, NWI = 2 * DFF, INW = 2304, NMODC = 9 * DM;
constexpr int NTHREADS = 512;
constexpr int LDS_BYTES = 139264;
constexpr int C_QA = 0, C_KA = 512, C_VA = 640, C_QR = 768, C_KR = 1024, C_VR = 1280, C_GR = 1792;
constexpr int NCH = 264;
constexpr float RMS_EPS = 1e-6f, GN_EPS = 1e-5f;

constexpr size_t MiB = 1u << 20;
constexpr size_t SZ_WI = (size_t)NWI * DM * 2, SZ_WO = (size_t)DM * DFF * 2, SZ_WIN = (size_t)INW * DM * 2, SZ_WOUT = (size_t)DM * DM * 2;
constexpr size_t OW_WI1 = 0, OW_WO1 = SZ_WI, OW_WIN = OW_WO1 + SZ_WO, OW_WOUT = OW_WIN + SZ_WIN, OW_WI2 = OW_WOUT + SZ_WOUT, OW_WO2 = OW_WI2 + SZ_WI, SZ_WL = OW_WO2 + SZ_WO;
static_assert(2 * SZ_WL <= 79 * MiB, "weights");
constexpr size_t WS_W = 0, WS_MOD = 79 * MiB, WS_RET = 80 * MiB, WS_AX = 82 * MiB, WS_HC = 83 * MiB, WS_U = 87 * MiB, WS_Y = 153 * MiB, WS_MIX = 219 * MiB, WS_ACT = 285 * MiB;
constexpr size_t WS_BAR = 82 * MiB + 512 * 1024;
constexpr size_t WS_H = WS_MIX;
constexpr size_t WS_KV = WS_Y, WS_SP = WS_Y + 33 * MiB;
static_assert((size_t)TROWS * DM * 2 == 66 * MiB && (size_t)2 * NCH * 4 * 8192 * 2 == 33 * MiB, "overlay sizes");
constexpr size_t WS_KT = WS_ACT + (size_t)TROWS * INW * 2;
constexpr size_t WS_VT = WS_ACT + (size_t)TROWS * DFF * 2;
static_assert(WS_KT + (size_t)256 * TROWS * 2 <= WS_VT, "kr^T fits behind proj");
constexpr size_t WS_PART = WS_VT;
constexpr size_t WS_END = WS_PART + (size_t)11 * NCTX * DM * 4;
static_assert(WS_END >= WS_VT + (size_t)640 * TROWS * 2 && WS_END <= 512 * MiB, "workspace");

struct Params { const float* in[18]; float* out; unsigned char* ws; };

__device__ __forceinline__ unsigned f2bf(float f) { unsigned u = __builtin_bit_cast(unsigned, f); return (u + 0x7fffu + ((u >> 16) & 1u)) >> 16; }
__device__ __forceinline__ unsigned pk2(float lo, float hi) { return pg8::cvt_pk_bf16(lo, hi); }
__device__ __forceinline__ float bflo(unsigned u) { return __builtin_bit_cast(float, u << 16); }
__device__ __forceinline__ float bfhi(unsigned u) { return __builtin_bit_cast(float, u & 0xffff0000u); }
__device__ __forceinline__ float bf2f(bf16_t b) { return __builtin_bit_cast(float, (unsigned)b << 16); }
__device__ __forceinline__ f32x8 unpack8(u32x4 v) { f32x8 o; o[0] = bflo(v.x); o[1] = bfhi(v.x); o[2] = bflo(v.y); o[3] = bfhi(v.y); o[4] = bflo(v.z); o[5] = bfhi(v.z); o[6] = bflo(v.w); o[7] = bfhi(v.w); return o; }
__device__ __forceinline__ u32x4 pack8(f32x8 v) { u32x4 o; o.x = pk2(v[0], v[1]); o.y = pk2(v[2], v[3]); o.z = pk2(v[4], v[5]); o.w = pk2(v[6], v[7]); return o; }
__device__ __forceinline__ float silu_f(float a) { return a * __builtin_amdgcn_rcpf(1.f + __expf(-a)); }
__device__ __forceinline__ float wave_sum(float v) {
#pragma unroll
    for (int o = 1; o < 64; o <<= 1) v += __shfl_xor(v, o);
    return v;
}
__device__ __forceinline__ float sum16(float v) { v += __shfl_xor(v, 1); v += __shfl_xor(v, 2); v += __shfl_xor(v, 4); v += __shfl_xor(v, 8); return v; }
__device__ __forceinline__ float max16(float v) { v = fmaxf(v, __shfl_xor(v, 1)); v = fmaxf(v, __shfl_xor(v, 2)); v = fmaxf(v, __shfl_xor(v, 4)); v = fmaxf(v, __shfl_xor(v, 8)); return v; }
__device__ __forceinline__ float logsig(float x) { return -log1pf(__expf(-x)); }
#define LDS_WAIT() asm volatile("s_waitcnt lgkmcnt(0)" ::: "memory")
#define WAVE_FENCE() do { asm volatile("s_waitcnt lgkmcnt(0)" ::: "memory"); __builtin_amdgcn_wave_barrier(); } while (0)

__device__ __forceinline__ int off64(int row, int col) { return row * 128 + ((((col >> 3) ^ (row & 7)) << 4) | ((col & 7) << 1)); }
__device__ __forceinline__ int off128(int row, int col) { return row * 256 + ((((col >> 3) ^ (row & 7)) << 4) | ((col & 7) << 1)); }
__device__ __forceinline__ bf16x8 lds_ld16(LAS unsigned char* base, int off) { return *(LAS bf16x8*)(base + off); }
__device__ __forceinline__ void lds_st16(LAS unsigned char* base, int off, u32x4 v) { *(LAS u32x4*)(base + off) = v; }
__device__ __forceinline__ void lds_st2(LAS unsigned char* base, int off, unsigned v) { *(LAS unsigned short*)(base + off) = (unsigned short)v; }
__device__ __forceinline__ f32x4 mfma16(bf16x8 a, bf16x8 b, f32x4 c) { return __builtin_amdgcn_mfma_f32_16x16x32_bf16(a, b, c, 0, 0, 0); }

__device__ __forceinline__ f32x8 load8(const bf16_t* rowptr, int c, int mode, const f32x2* cs) {
    f32x8 o = unpack8(*(const u32x4*)(rowptr + c * 8));
    if (mode) {
        const int pc = (mode == 1) ? (c ^ 2) : (c ^ 4);
        const bool isx2 = (mode == 1) ? ((c >> 1) & 1) : ((c >> 2) & 1);
        const f32x8 pp = unpack8(*(const u32x4*)(rowptr + pc * 8));
#pragma unroll
        for (int j = 0; j < 8; ++j) { const f32x2 t = cs[j]; o[j] = o[j] * t.x + (isx2 ? pp[j] : -pp[j]) * t.y; }
    }
    return o;
}

struct EpiStoreBf16 {
    static constexpr bool PERM = true, AFTER_DRAIN = false;
    bf16_t* O; int ldc;
    __device__ __forceinline__ void operator()(const f32x4 (&acc)[2][2][4][2], const pg8::Unit& u, int wr, int wc, int fr, int fq) const {
        const int row0 = u.pm * 256 + wr * 64 + fr, col0 = u.pn * 256 + wc * 32 + 8 * fq;
#pragma unroll
        for (int ai = 0; ai < 2; ++ai)
#pragma unroll
            for (int m = 0; m < 4; ++m) { bf16_t* rowp = O + (size_t)(row0 + ai * 128 + m * 16) * ldc + col0;
#pragma unroll
                for (int bj = 0; bj < 2; ++bj) { const f32x4 v0 = acc[ai][bj][m][0], v1 = acc[ai][bj][m][1];
                    u32x4 w; w.x = pk2(v0[0], v0[1]); w.y = pk2(v0[2], v0[3]); w.z = pk2(v1[0], v1[1]); w.w = pk2(v1[2], v1[3]);
                    *(u32x4*)(rowp + bj * 128) = w; } }
    }
};
struct EpiSwiglu {
    static constexpr bool PERM = true, AFTER_DRAIN = false;
    bf16_t* O;
    __device__ __forceinline__ void operator()(const f32x4 (&acc)[2][2][4][2], const pg8::Unit& u, int wr, int wc, int fr, int fq) const {
        const int row0 = u.pm * 256 + wr * 64 + fr, col0 = u.pn * 128 + wc * 32 + 8 * fq;
#pragma unroll
        for (int ai = 0; ai < 2; ++ai)
#pragma unroll
            for (int m = 0; m < 4; ++m) { bf16_t* rowp = O + (size_t)(row0 + ai * 128 + m * 16) * DFF + col0;
                const f32x4 a0 = acc[ai][0][m][0], a1 = acc[ai][0][m][1], b0 = acc[ai][1][m][0], b1 = acc[ai][1][m][1];
                u32x4 w; w.x = pk2(silu_f(a0[0]) * b0[0], silu_f(a0[1]) * b0[1]); w.y = pk2(silu_f(a0[2]) * b0[2], silu_f(a0[3]) * b0[3]);
                w.z = pk2(silu_f(a1[0]) * b1[0], silu_f(a1[1]) * b1[1]); w.w = pk2(silu_f(a1[2]) * b1[2], silu_f(a1[3]) * b1[3]);
                *(u32x4*)rowp = w; }
    }
};

__device__ __forceinline__ void transpose_item(const float* W, int K, int N, bf16_t* WT, int mode, LAS float* scr, int item, int lane) {
    const int nblk = N / 32, kb = item / nblk, nb = item % nblk, k0 = 64 * kb, n0 = 32 * nb;
#pragma unroll 8
    for (int i = 0; i < 32; ++i) { const int kk = 2 * i + (lane >> 5); scr[kk * 33 + (lane & 31)] = W[(size_t)(k0 + kk) * N + n0 + (lane & 31)]; }
    LDS_WAIT();
    int on0 = n0; float sc = 1.f;
    if (mode == 1) { if (n0 < DFF) on0 = (n0 >> 7) * 256 + (n0 & 127); else { const int mm = n0 - DFF; on0 = (mm >> 7) * 256 + 128 + (mm & 127); } }
    else if (mode == 2) { if (n0 < 512 || (n0 >= C_KR && n0 < C_VR)) sc = 0.125f; }
    const int c = lane & 7;
#pragma unroll
    for (int j = 0; j < 4; ++j) { const int n = (lane >> 3) + 8 * j; const LAS float* s = scr + (8 * c) * 33 + n;
        u32x4 o; o.x = pk2(s[0 * 33] * sc, s[1 * 33] * sc); o.y = pk2(s[2 * 33] * sc, s[3 * 33] * sc); o.z = pk2(s[4 * 33] * sc, s[5 * 33] * sc); o.w = pk2(s[6 * 33] * sc, s[7 * 33] * sc);
        int orow = on0 + n;
        if (mode == 2) { const int sc_ = n0 + n, d = sc_ & 63;
            if (sc_ < 640) { const int dd = d & 31; orow = (sc_ & ~63) + 8 * ((d >> 5) * 4 + ((dd & 15) >> 2)) + 4 * (dd >> 4) + (dd & 3); }
            else if (sc_ >= C_QR && sc_ < C_VR) { const int ff = d & 31; orow = (sc_ & ~63) + 8 * (ff >> 2) + 4 * (d >> 5) + (ff & 3); } }
        *(u32x4*)(WT + (size_t)orow * K + k0 + 8 * c) = o; }
    LDS_WAIT();
}

__device__ __forceinline__ void sincos_tab(float angf, float& s, float& c) {
    const double a = (double)angf; const double q = rint(a * 0.63661977236758134308);
    const double r = fma(-q, 1.57079632679489661923, a), r2 = r * r;
    const double sp = r * (1.0 + r2 * (-1.0 / 6.0 + r2 * (1.0 / 120.0 + r2 * (-1.0 / 5040.0 + r2 * (1.0 / 362880.0 + r2 * (-1.0 / 39916800.0 + r2 * (1.0 / 6227020800.0)))))));
    const double cp = 1.0 + r2 * (-0.5 + r2 * (1.0 / 24.0 + r2 * (-1.0 / 720.0 + r2 * (1.0 / 40320.0 + r2 * (-1.0 / 3628800.0 + r2 * (1.0 / 479001600.0))))));
    const int qi = ((int)q) & 3;
    const double ss = (qi == 0) ? sp : (qi == 1) ? cp : (qi == 2) ? -sp : -cp;
    const double cc = (qi == 0) ? cp : (qi == 1) ? -sp : (qi == 2) ? -cp : sp;
    s = (float)ss; c = (float)cc;
}

__device__ __forceinline__ void p0_phase(const Params& p, LAS unsigned char* lds, int tid, int lane, int wave) {
    unsigned char* ws = p.ws;
    {
        LAS float* scr = (LAS float*)(lds + wave * 16384);
        const int gw = blockIdx.x * 8 + wave, NGW = gridDim.x * 8;
        constexpr int I_WI = (DM / 64) * (NWI / 32), I_WO = (DFF / 64) * (DM / 32), I_WIN = (DM / 64) * (INW / 32), I_WOUT = (DM / 64) * (DM / 32);
        constexpr int LT = 2 * I_WI + 2 * I_WO + I_WIN + I_WOUT;
        for (int it = gw; it < 2 * LT; it += NGW) {
            const int l = it / LT; int r = it % LT;
            bf16_t* wl = (bf16_t*)(ws + WS_W + (size_t)l * SZ_WL);
            if (r < I_WI) { transpose_item(p.in[8] + (size_t)l * DM * NWI, DM, NWI, wl + OW_WI1 / 2, 1, scr, r, lane); continue; } r -= I_WI;
            if (r < I_WO) { transpose_item(p.in[9] + (size_t)l * DFF * DM, DFF, DM, wl + OW_WO1 / 2, 0, scr, r, lane); continue; } r -= I_WO;
            if (r < I_WIN) { transpose_item(p.in[12] + (size_t)l * DM * INW, DM, INW, wl + OW_WIN / 2, 2, scr, r, lane); continue; } r -= I_WIN;
            if (r < I_WOUT) { transpose_item(p.in[13] + (size_t)l * DM * DM, DM, DM, wl + OW_WOUT / 2, 0, scr, r, lane); continue; } r -= I_WOUT;
            if (r < I_WI) { transpose_item(p.in[10] + (size_t)l * DM * NWI, DM, NWI, wl + OW_WI2 / 2, 1, scr, r, lane); continue; } r -= I_WI;
            transpose_item(p.in[11] + (size_t)l * DFF * DM, DFF, DM, wl + OW_WO2 / 2, 0, scr, r, lane);
        }
    }
    __syncthreads();
    {
        LAS float* sil = (LAS float*)lds;
        LAS float* red = (LAS float*)(lds + 32768);
        float* mod = (float*)(ws + WS_MOD);
        for (int i = tid; i < 5 * DM; i += NTHREADS) { const int set = i >> 10, k = i & 1023; const float v = set < 4 ? p.in[1][set * DM + k] : p.in[3][k]; sil[i] = v / (1.f + __expf(-v)); }
        __syncthreads();
        const int kg = tid >> 6, jc = tid & 63;
        for (int ch = blockIdx.x; ch < 2 * (NMODC / 64); ch += gridDim.x) {
            const int l = ch / (NMODC / 64), j0 = (ch % (NMODC / 64)) * 64;
            const float* wp = p.in[4] + ((size_t)l * DM + kg * 128) * NMODC + j0 + jc;
            float a0 = 0.f, a1 = 0.f, a2 = 0.f, a3 = 0.f, a4 = 0.f;
#pragma unroll 32
            for (int k = 0; k < 128; ++k) { const float w = wp[(size_t)k * NMODC]; const int kk = kg * 128 + k;
                a0 += sil[kk] * w; a1 += sil[1024 + kk] * w; a2 += sil[2048 + kk] * w; a3 += sil[3072 + kk] * w; a4 += sil[4096 + kk] * w; }
            red[(kg * 5 + 0) * 64 + jc] = a0; red[(kg * 5 + 1) * 64 + jc] = a1; red[(kg * 5 + 2) * 64 + jc] = a2; red[(kg * 5 + 3) * 64 + jc] = a3; red[(kg * 5 + 4) * 64 + jc] = a4;
            __syncthreads();
            if (tid < 320) { const int s = tid >> 6; float v = p.in[5][l * NMODC + j0 + jc];
#pragma unroll
                for (int g = 0; g < 8; ++g) v += red[(g * 5 + s) * 64 + jc];
                mod[(size_t)(l * 5 + s) * NMODC + j0 + jc] = v; }
            __syncthreads();
        }
    }
    {
        static const float inv32[32] = {1.000000000e+00f, 7.429639697e-01f, 5.519954562e-01f, 4.101127088e-01f, 3.046989739e-01f, 2.263803482e-01f, 1.681924462e-01f, 1.249609217e-01f,
            9.284146130e-02f, 6.897786260e-02f, 5.124806240e-02f, 3.807546198e-02f, 2.828869782e-02f, 2.101748250e-02f, 1.561523229e-02f, 1.160155516e-02f,
            8.619536646e-03f, 6.404003594e-03f, 4.757944960e-03f, 3.534980817e-03f, 2.626364119e-03f, 1.951293205e-03f, 1.449740957e-03f, 1.077104942e-03f,
            8.002503891e-04f, 5.945570301e-04f, 4.417345626e-04f, 3.281927784e-04f, 2.438354713e-04f, 1.811609254e-04f, 1.345960773e-04f, 9.999999747e-05f};
        static const float inv16[16] = {1.000000000e+00f, 5.623413324e-01f, 3.162277639e-01f, 1.778279394e-01f, 1.000000015e-01f, 5.623413250e-02f, 3.162277490e-02f, 1.778279431e-02f,
            9.999999776e-03f, 5.623413250e-03f, 3.162277630e-03f, 1.778279431e-03f, 1.000000047e-03f, 5.623413017e-04f, 3.162277571e-04f, 1.778279402e-04f};
        f32x2* rt = (f32x2*)(ws + WS_RET); f32x2* ax = (f32x2*)(ws + WS_AX);
        const int gt = blockIdx.x * NTHREADS + tid, NT = gridDim.x * NTHREADS;
        for (int i = gt; i < SEQ * 32 + 192 * 16; i += NT) {
            float ang; f32x2* dst;
            if (i < SEQ * 32) { ang = (float)(i >> 5) * inv32[i & 31]; dst = rt + i; }
            else { const int j = i - SEQ * 32, idx = j >> 4; ang = (float)(idx < 128 ? idx : idx - 128) * inv16[j & 15]; dst = ax + j; }
            float s, c; sincos_tab(ang, s, c); *dst = (f32x2){c, s};
        }
    }
}

__device__ __forceinline__ void norm_phase(int nrows, const bf16_t* __restrict__ y, const bf16_t* __restrict__ ypart, int nsplit, const float* __restrict__ hs_lat, const float* __restrict__ hs_ctx, bf16_t* hb, float* __restrict__ out_f32,
                                           float rs, const float* __restrict__ mod_g, int gate_idx, const float* __restrict__ gpost,
                                           bool do_u, const float* __restrict__ mod_u, int shift_idx, int scale_idx, const float* __restrict__ gpre, bf16_t* __restrict__ u, int lane, int wave) {
    const int gw = blockIdx.x * 8 + wave, NGW = gridDim.x * 8, nlatch = NLAT >> 4, nitems = nlatch + (nrows - NLAT);
    for (int ch = gw; ch < nitems; ch += NGW) {
        const bool single = ch >= nlatch;
        const int row0 = single ? NLAT + (ch - nlatch) : ch * 16, set = row0 < NLAT ? row0 / SEQ : 4;
        f32x4 gg[4], pa[4], pb[4];
#pragma unroll
        for (int j = 0; j < 4; ++j) { const int col = 4 * lane + 256 * j;
            if (y) gg[j] = *(const f32x4*)(mod_g + (size_t)set * NMODC + gate_idx * DM + col) * *(const f32x4*)(gpost + col) * rs;
            if (do_u) { pa[j] = *(const f32x4*)(gpre + col) * (*(const f32x4*)(mod_u + (size_t)set * NMODC + scale_idx * DM + col) + 1.f); pb[j] = *(const f32x4*)(mod_u + (size_t)set * NMODC + shift_idx * DM + col); } }
#pragma unroll 1
        for (int g = 0; g < (single ? 4 : 16); g += 4) {
            f32x4 hv[4][4]; u32x2 yw[4][4];
#pragma unroll
            for (int q = 0; q < 4; ++q) { if (single && q > 0) continue;
                const int row = single ? row0 : row0 + g + q;
                if (hs_lat) { const float* hs = row < NLAT ? hs_lat + (size_t)row * DM : hs_ctx + (size_t)(row - NLAT) * DM;
#pragma unroll
                    for (int j = 0; j < 4; ++j) hv[q][j] = *(const f32x4*)(hs + 4 * lane + 256 * j); }
                else {
#pragma unroll
                    for (int j = 0; j < 4; ++j) { const u32x2 w = *(const u32x2*)(hb + (size_t)row * DM + 4 * lane + 256 * j); hv[q][j] = (f32x4){bflo(w.x), bfhi(w.x), bflo(w.y), bfhi(w.y)}; } }
                if (y && !(single && ypart)) {
#pragma unroll
                    for (int j = 0; j < 4; ++j) yw[q][j] = *(const u32x2*)(y + (size_t)row * DM + 4 * lane + 256 * j);
                } }
#pragma unroll
            for (int q = 0; q < 4; ++q) { if (single && q > 0) continue;
                const int row = single ? row0 : row0 + g + q;
                if (y) {
                    f32x4 yv[4]; float ss = 0.f;
                    if (single && ypart) {
#pragma unroll
                        for (int j = 0; j < 4; ++j) yv[j] = (f32x4){0.f, 0.f, 0.f, 0.f};
#pragma unroll 1
                        for (int sp0 = 0; sp0 < nsplit; sp0 += 6) {
                            u32x2 t[6][4];
#pragma unroll
                            for (int s4 = 0; s4 < 6; ++s4) { const int sp_ = (sp0 + s4 < nsplit) ? sp0 + s4 : sp0;
#pragma unroll
                                for (int j = 0; j < 4; ++j) t[s4][j] = *(const u32x2*)(ypart + ((size_t)sp_ * NCTX + (row - NLAT)) * DM + 4 * lane + 256 * j); }
#pragma unroll
                            for (int s4 = 0; s4 < 6; ++s4) { if (sp0 + s4 < nsplit) {
#pragma unroll
                                for (int j = 0; j < 4; ++j) yv[j] = yv[j] + (f32x4){bflo(t[s4][j].x), bfhi(t[s4][j].x), bflo(t[s4][j].y), bfhi(t[s4][j].y)}; } }
                        }
                    }
#pragma unroll
                    for (int j = 0; j < 4; ++j) { const u32x2 w = yw[q][j];
                        if (!(single && ypart)) yv[j] = (f32x4){bflo(w.x), bfhi(w.x), bflo(w.y), bfhi(w.y)};
                        ss += (yv[j].x * yv[j].x + yv[j].y * yv[j].y) + (yv[j].z * yv[j].z + yv[j].w * yv[j].w); }
                    const float r = __builtin_amdgcn_rsqf(wave_sum(ss) * (1.f / DM) + RMS_EPS);
#pragma unroll
                    for (int j = 0; j < 4; ++j) { const int col = 4 * lane + 256 * j;
                        hv[q][j] = hv[q][j] + (yv[j] * r) * gg[j];
                        if (out_f32) *(f32x4*)(out_f32 + (size_t)row * DM + col) = hv[q][j];
                        else { u32x2 w; w.x = pk2(hv[q][j].x, hv[q][j].y); w.y = pk2(hv[q][j].z, hv[q][j].w); *(u32x2*)(hb + (size_t)row * DM + col) = w;
                               hv[q][j] = (f32x4){bflo(w.x), bfhi(w.x), bflo(w.y), bfhi(w.y)}; } }
                }
                if (do_u) {
                    float ss = 0.f;
#pragma unroll
                    for (int j = 0; j < 4; ++j) ss += (hv[q][j].x * hv[q][j].x + hv[q][j].y * hv[q][j].y) + (hv[q][j].z * hv[q][j].z + hv[q][j].w * hv[q][j].w);
                    const float r = __builtin_amdgcn_rsqf(wave_sum(ss) * (1.f / DM) + RMS_EPS);
#pragma unroll
                    for (int j = 0; j < 4; ++j) { const int col = 4 * lane + 256 * j;
                        const f32x4 o = (hv[q][j] * r) * pa[j] + pb[j];
                        u32x2 w; w.x = pk2(o.x, o.y); w.y = pk2(o.z, o.w); *(u32x2*)(u + (size_t)row * DM + col) = w; }
                }
            }
        }
    }
}

__device__ __forceinline__ void norm_phase8(int nrows, const bf16_t* __restrict__ y, const bf16_t* __restrict__ ypart, int nsplit, const float* __restrict__ hs_lat, const float* __restrict__ hs_ctx, bf16_t* hb, float* __restrict__ out_f32,
                                           float rs, const float* __restrict__ mod_g, int gate_idx, const float* __restrict__ gpost,
                                           bool do_u, const float* __restrict__ mod_u, int shift_idx, int scale_idx, const float* __restrict__ gpre, bf16_t* __restrict__ u, int lane, int wave) {
    const int gw = blockIdx.x * 8 + wave, NGW = gridDim.x * 8, nlatch = NLAT >> 4, nitems = nlatch + (nrows - NLAT);
    for (int ch = gw; ch < nitems; ch += NGW) {
        const bool single = ch >= nlatch;
        const int row0 = single ? NLAT + (ch - nlatch) : ch * 16, set = row0 < NLAT ? row0 / SEQ : 4;
        f32x4 gg[4], pa[4], pb[4];
#pragma unroll
        for (int j = 0; j < 4; ++j) { const int col = 4 * lane + 256 * j;
            if (y) gg[j] = *(const f32x4*)(mod_g + (size_t)set * NMODC + gate_idx * DM + col) * *(const f32x4*)(gpost + col) * rs;
            if (do_u) { pa[j] = *(const f32x4*)(gpre + col) * (*(const f32x4*)(mod_u + (size_t)set * NMODC + scale_idx * DM + col) + 1.f); pb[j] = *(const f32x4*)(mod_u + (size_t)set * NMODC + shift_idx * DM + col); } }
#pragma unroll 1
        for (int g = 0; g < (single ? 6 : 16); g += 6) {
            u32x2 hw[6][4]; u32x2 yw[6][4];
#pragma unroll
            for (int q = 0; q < 6; ++q) { if ((single && q > 0) || g + q >= 16) continue;
                const int row = single ? row0 : row0 + g + q;
#pragma unroll
                for (int j = 0; j < 4; ++j) hw[q][j] = *(const u32x2*)(hb + (size_t)row * DM + 4 * lane + 256 * j);
                if (y && !(single && ypart)) {
#pragma unroll
                    for (int j = 0; j < 4; ++j) yw[q][j] = *(const u32x2*)(y + (size_t)row * DM + 4 * lane + 256 * j);
                } }
#pragma unroll
            for (int q = 0; q < 6; ++q) { if ((single && q > 0) || g + q >= 16) continue;
                const int row = single ? row0 : row0 + g + q;
                f32x4 hv[4];
#pragma unroll
                for (int j = 0; j < 4; ++j) { const u32x2 w = hw[q][j]; hv[j] = (f32x4){bflo(w.x), bfhi(w.x), bflo(w.y), bfhi(w.y)}; }
                if (y) {
                    f32x4 yv[4]; float ss = 0.f;
                    if (single && ypart) {
#pragma unroll
                        for (int j = 0; j < 4; ++j) yv[j] = (f32x4){0.f, 0.f, 0.f, 0.f};
#pragma unroll 1
                        for (int sp0 = 0; sp0 < nsplit; sp0 += 6) {
                            u32x2 t[6][4];
#pragma unroll
                            for (int s4 = 0; s4 < 6; ++s4) { const int sp_ = (sp0 + s4 < nsplit) ? sp0 + s4 : sp0;
#pragma unroll
                                for (int j = 0; j < 4; ++j) t[s4][j] = *(const u32x2*)(ypart + ((size_t)sp_ * NCTX + (row - NLAT)) * DM + 4 * lane + 256 * j); }
#pragma unroll
                            for (int s4 = 0; s4 < 6; ++s4) { if (sp0 + s4 < nsplit) {
#pragma unroll
                                for (int j = 0; j < 4; ++j) yv[j] = yv[j] + (f32x4){bflo(t[s4][j].x), bfhi(t[s4][j].x), bflo(t[s4][j].y), bfhi(t[s4][j].y)}; } }
                        }
                    }
#pragma unroll
                    for (int j = 0; j < 4; ++j) { const u32x2 w = yw[q][j];
                        if (!(single && ypart)) yv[j] = (f32x4){bflo(w.x), bfhi(w.x), bflo(w.y), bfhi(w.y)};
                        ss += (yv[j].x * yv[j].x + yv[j].y * yv[j].y) + (yv[j].z * yv[j].z + yv[j].w * yv[j].w); }
                    const float r = __builtin_amdgcn_rsqf(wave_sum(ss) * (1.f / DM) + RMS_EPS);
#pragma unroll
                    for (int j = 0; j < 4; ++j) { const int col = 4 * lane + 256 * j;
                        hv[j] = hv[j] + (yv[j] * r) * gg[j];
                        if (out_f32) *(f32x4*)(out_f32 + (size_t)row * DM + col) = hv[j];
                        else { u32x2 w; w.x = pk2(hv[j].x, hv[j].y); w.y = pk2(hv[j].z, hv[j].w); *(u32x2*)(hb + (size_t)row * DM + col) = w;
                               hv[j] = (f32x4){bflo(w.x), bfhi(w.x), bflo(w.y), bfhi(w.y)}; } }
                }
                if (do_u) {
                    float ss = 0.f;
#pragma unroll
                    for (int j = 0; j < 4; ++j) ss += (hv[j].x * hv[j].x + hv[j].y * hv[j].y) + (hv[j].z * hv[j].z + hv[j].w * hv[j].w);
                    const float r = __builtin_amdgcn_rsqf(wave_sum(ss) * (1.f / DM) + RMS_EPS);
#pragma unroll
                    for (int j = 0; j < 4; ++j) { const int col = 4 * lane + 256 * j;
                        const f32x4 o = (hv[j] * r) * pa[j] + pb[j];
                        u32x2 w; w.x = pk2(o.x, o.y); w.y = pk2(o.z, o.w); *(u32x2*)(u + (size_t)row * DM + col) = w; }
                }
            }
        }
    }
}

__device__ __forceinline__ void prenorm_phase(int nrows, const float* __restrict__ hs_lat, const float* __restrict__ hs_ctx, const float* __restrict__ mod_u, int shift_idx, int scale_idx,
                                              const float* __restrict__ gpre, bf16_t* __restrict__ u, int lane, int wave) {
    const int gw = blockIdx.x * 8 + wave, NGW = gridDim.x * 8, nlatch = NLAT >> 4, nitems = nlatch + (nrows - NLAT);
    for (int ch = gw; ch < nitems; ch += NGW) {
        const bool single = ch >= nlatch;
        const int row0 = single ? NLAT + (ch - nlatch) : ch * 16, set = row0 < NLAT ? row0 / SEQ : 4;
        f32x4 pa[4], pb[4];
#pragma unroll
        for (int j = 0; j < 4; ++j) { const int col = 4 * lane + 256 * j;
            pa[j] = *(const f32x4*)(gpre + col) * (*(const f32x4*)(mod_u + (size_t)set * NMODC + scale_idx * DM + col) + 1.f); pb[j] = *(const f32x4*)(mod_u + (size_t)set * NMODC + shift_idx * DM + col); }
#pragma unroll 1
        for (int g = 0; g < (single ? 8 : 16); g += 8) {
            f32x4 hv[8][4];
#pragma unroll
            for (int q = 0; q < 8; ++q) { if (single && q > 0) continue;
                const int row = single ? row0 : row0 + g + q;
                const float* hs = row < NLAT ? hs_lat + (size_t)row * DM : hs_ctx + (size_t)(row - NLAT) * DM;
#pragma unroll
                for (int j = 0; j < 4; ++j) hv[q][j] = *(const f32x4*)(hs + 4 * lane + 256 * j); }
#pragma unroll
            for (int q = 0; q < 8; ++q) { if (single && q > 0) continue;
                const int row = single ? row0 : row0 + g + q;
                float ss = 0.f;
#pragma unroll
                for (int j = 0; j < 4; ++j) ss += (hv[q][j].x * hv[q][j].x + hv[q][j].y * hv[q][j].y) + (hv[q][j].z * hv[q][j].z + hv[q][j].w * hv[q][j].w);
                const float r = __builtin_amdgcn_rsqf(wave_sum(ss) * (1.f / DM) + RMS_EPS);
#pragma unroll
                for (int j = 0; j < 4; ++j) { const int col = 4 * lane + 256 * j;
                    const f32x4 o = (hv[q][j] * r) * pa[j] + pb[j];
                    u32x2 w; w.x = pk2(o.x, o.y); w.y = pk2(o.z, o.w); *(u32x2*)(u + (size_t)row * DM + col) = w; }
            }
        }
    }
}

typedef unsigned long long u64_t;
__device__ __forceinline__ bf16x8 gld16(const bf16_t* p) { return *(const bf16x8*)p; }
__device__ __forceinline__ bf16x8 gld8x2(const bf16_t* p0, const bf16_t* p1) { const u32x2 a = *(const u32x2*)p0, b = *(const u32x2*)p1; u32x4 w; w.x = a.x; w.y = a.y; w.z = b.x; w.w = b.y; return __builtin_bit_cast(bf16x8, w); }
__device__ __forceinline__ float max4q(float v) { v = fmaxf(v, __shfl_xor(v, 16)); v = fmaxf(v, __shfl_xor(v, 32)); return v; }
__device__ __forceinline__ float sum4q(float v) { v += __shfl_xor(v, 16); v += __shfl_xor(v, 32); return v; }
constexpr int AT_STAGE = 16384;
__device__ __forceinline__ void attn_unit(LAS unsigned char* lds, int uid, const bf16_t* __restrict__ proj, const bf16_t* __restrict__ vt, bf16_t* __restrict__ mix, const float* sinkp, int tid, int lane, int wave) {
    constexpr float L2E = 1.4426950408889634f;
    const bool isctx = uid >= 1024;
    int b, kvh, nb, hp;
    if (!isctx) { hp = (uid >> 3) & 1; const int r_ = ((uid >> 4) << 3) | (uid & 7); kvh = r_ & 1; nb = (r_ >> 1) & 63; b = r_ >> 7; }
    else { const int c = uid - 1024; hp = c & 1; kvh = (c >> 1) & 1; nb = (c >> 2) & 1; b = c >> 3; }
    const int qrow0 = isctx ? NLAT + b * CTXL + nb * 128 : b * SEQ + nb * 128;
    const int qpos0 = nb * 128;
    const int fr = lane & 15, fq = lane >> 4;
    const int h = kvh * 4 + hp * 2 + (wave >> 2);
    const int qi0 = (wave & 3) * 32;
    const float sink2 = sinkp[h] * L2E;
    bf16x8 qf[2][2];
#pragma unroll
    for (int rt = 0; rt < 2; ++rt)
#pragma unroll
        for (int kc = 0; kc < 2; ++kc) qf[rt][kc] = gld16(proj + (size_t)(qrow0 + qi0 + rt * 16 + fr) * INW + C_QA + h * 64 + kc * 32 + fq * 8);
    float m2[2], lsum[2]; f32x4 O[2][4];
#pragma unroll
    for (int rt = 0; rt < 2; ++rt) { m2[rt] = sink2; lsum[rt] = (fq == 0) ? 1.f : 0.f;
#pragma unroll
        for (int dt = 0; dt < 4; ++dt) O[rt][dt] = (f32x4){0.f, 0.f, 0.f, 0.f}; }
    const int tb0 = isctx ? 0 : (nb == 0 ? 2 : 0), tb1 = isctx ? 0 : (nb == 63 ? 4 : 6), nband = tb1 - tb0, ntile = nband + 4;
    const int srow = tid >> 3, sch = tid & 7;
    const bf16_t* kg = proj + C_KA + kvh * 64 + sch * 8 + (size_t)srow * INW;
    const bf16_t* vg = vt + (size_t)(kvh * 64 + srow) * TROWS + sch * 8;
    const int sto = srow * 128 + ((sch ^ (srow & 7)) << 4);
    const int kr0 = (fr >> 2) * 8 + (fr & 3);
    const int ko00 = kr0 * 128 + (((fq) ^ (kr0 & 7)) << 4), ko01 = kr0 * 128 + (((4 + fq) ^ (kr0 & 7)) << 4);
    const int ko10 = (kr0 + 4) * 128 + (((fq) ^ ((kr0 + 4) & 7)) << 4), ko11 = (kr0 + 4) * 128 + (((4 + fq) ^ ((kr0 + 4) & 7)) << 4);
    const int vo0 = 8192 + fr * 128 + (((fq) ^ (fr & 7)) << 4), vo1 = 8192 + fr * 128 + (((4 + fq) ^ (fr & 7)) << 4);
#define AT_KROW(jj) (((jj) < nband) ? b * SEQ + (nb - 1) * 128 + (tb0 + (jj)) * 64 : NLAT + b * CTXL + ((jj) - nband) * 64)
    __syncthreads();
    u32x4 kreg, vreg;
    { const int kr = AT_KROW(0); kreg = *(const u32x4*)(kg + (size_t)kr * INW); vreg = *(const u32x4*)(vg + kr); }
    lds_st16(lds, sto, kreg); lds_st16(lds, 8192 + sto, vreg);
    if (ntile > 1) { const int kr = AT_KROW(1); kreg = *(const u32x4*)(kg + (size_t)kr * INW); vreg = *(const u32x4*)(vg + kr); }
    __syncthreads();
#pragma unroll 1
    for (int j = 0; j < ntile; ++j) {
        const bool band = j < nband;
        const int kp0 = (nb - 1) * 128 + (tb0 + j) * 64;
        LAS unsigned char* st = lds + (j & 1) * AT_STAGE;
        if (j + 1 < ntile) { LAS unsigned char* sn = lds + ((j + 1) & 1) * AT_STAGE; lds_st16(sn, sto, kreg); lds_st16(sn, 8192 + sto, vreg); }
        if (j + 2 < ntile) { const int kr = AT_KROW(j + 2); kreg = *(const u32x4*)(kg + (size_t)kr * INW); vreg = *(const u32x4*)(vg + kr); }
        f32x4 s[2][4];
#pragma unroll
        for (int pi = 0; pi < 2; ++pi) {
            const bf16x8 k00 = lds_ld16(st, pi * 4096 + ko00), k01 = lds_ld16(st, pi * 4096 + ko01), k10 = lds_ld16(st, pi * 4096 + ko10), k11 = lds_ld16(st, pi * 4096 + ko11);
#pragma unroll
            for (int rt = 0; rt < 2; ++rt) {
                s[rt][2 * pi] = mfma16(k00, qf[rt][0], (f32x4){0.f, 0.f, 0.f, 0.f}); s[rt][2 * pi] = mfma16(k01, qf[rt][1], s[rt][2 * pi]);
                s[rt][2 * pi + 1] = mfma16(k10, qf[rt][0], (f32x4){0.f, 0.f, 0.f, 0.f}); s[rt][2 * pi + 1] = mfma16(k11, qf[rt][1], s[rt][2 * pi + 1]); }
        }
        bf16x8 vf[4][2];
#pragma unroll
        for (int dt = 0; dt < 4; ++dt) { vf[dt][0] = lds_ld16(st, dt * 2048 + vo0); vf[dt][1] = lds_ld16(st, dt * 2048 + vo1); }
#pragma unroll
        for (int rt = 0; rt < 2; ++rt) {
            const int qlo = qpos0 + qi0 + rt * 16;
            if (band && (kp0 + 63 - qlo > 128 || qlo + 15 - kp0 > 128)) {
                const int dbase = (kp0 + fq * 8) - (qlo + fr);
#pragma unroll
                for (int n = 0; n < 4; ++n)
#pragma unroll
                    for (int r = 0; r < 4; ++r) { const int d = dbase + (n >> 1) * 32 + (n & 1) * 4 + r; if (d > 128 || d < -128) s[rt][n][r] = -1e30f; }
            }
            float mx = fmaxf(fmaxf(fmaxf(s[rt][0][0], s[rt][0][1]), fmaxf(s[rt][0][2], s[rt][0][3])), fmaxf(fmaxf(s[rt][1][0], s[rt][1][1]), fmaxf(s[rt][1][2], s[rt][1][3])));
            mx = fmaxf(mx, fmaxf(fmaxf(fmaxf(s[rt][2][0], s[rt][2][1]), fmaxf(s[rt][2][2], s[rt][2][3])), fmaxf(fmaxf(s[rt][3][0], s[rt][3][1]), fmaxf(s[rt][3][2], s[rt][3][3]))));
            mx = max4q(mx);
            const float mn = fmaxf(m2[rt], mx * L2E), alpha = __builtin_amdgcn_exp2f(m2[rt] - mn); m2[rt] = mn;
            float ps = 0.f;
#pragma unroll
            for (int n = 0; n < 4; ++n)
#pragma unroll
                for (int r = 0; r < 4; ++r) { const float pv = __builtin_amdgcn_exp2f(__builtin_fmaf(s[rt][n][r], L2E, -mn)); s[rt][n][r] = pv; ps += pv; }
            lsum[rt] = lsum[rt] * alpha + ps;
#pragma unroll
            for (int dt = 0; dt < 4; ++dt) O[rt][dt] = O[rt][dt] * alpha;
#pragma unroll
            for (int pi = 0; pi < 2; ++pi) { u32x4 w; w.x = pk2(s[rt][2 * pi][0], s[rt][2 * pi][1]); w.y = pk2(s[rt][2 * pi][2], s[rt][2 * pi][3]); w.z = pk2(s[rt][2 * pi + 1][0], s[rt][2 * pi + 1][1]); w.w = pk2(s[rt][2 * pi + 1][2], s[rt][2 * pi + 1][3]);
                const bf16x8 pb = __builtin_bit_cast(bf16x8, w);
#pragma unroll
                for (int dt = 0; dt < 4; ++dt) O[rt][dt] = mfma16(vf[dt][pi], pb, O[rt][dt]); }
        }
        __syncthreads();
    }
#undef AT_KROW
#pragma unroll
    for (int rt = 0; rt < 2; ++rt) { const float inv = 1.f / sum4q(lsum[rt]);
        bf16_t* op = mix + (size_t)(qrow0 + qi0 + rt * 16 + fr) * DM + h * 64 + fq * 4;
#pragma unroll
        for (int dt = 0; dt < 4; ++dt) { u32x2 w; w.x = pk2(O[rt][dt][0] * inv, O[rt][dt][1] * inv); w.y = pk2(O[rt][dt][2] * inv, O[rt][dt][3] * inv); *(u32x2*)(op + dt * 16) = w; } }
}

__device__ __forceinline__ bf16x8 scale_frag8(bf16x8 a, float base, const float (&pj)[8]) {
    const u32x4 u = __builtin_bit_cast(u32x4, a); f32x8 f = unpack8(u);
#pragma unroll
    for (int i = 0; i < 8; ++i) f[i] *= base * pj[i];
    return __builtin_bit_cast(bf16x8, pack8(f));
}
struct KvRegs { u32x4 v[4], k[2]; };
__device__ __forceinline__ void kv_load(KvRegs& R, int uid, const bf16_t* __restrict__ vt, const bf16_t* __restrict__ kt, int tid) {
    const int sqc = uid >> 2, h = uid & 3, row0 = sqc * 128;
#pragma unroll
    for (int k = 0; k < 4; ++k) { const int i = tid + 512 * k, e = i >> 4, c = i & 15; R.v[k] = *(const u32x4*)(vt + (size_t)(128 + h * 128 + e) * TROWS + row0 + c * 8); }
#pragma unroll
    for (int k = 0; k < 2; ++k) { const int i = tid + 512 * k, d = i >> 4, c = i & 15; R.k[k] = *(const u32x4*)(kt + (size_t)(h * 64 + d) * TROWS + row0 + c * 8); }
}
__device__ __forceinline__ void kv_store(const KvRegs& R, LAS unsigned char* lds, int tid) {
#pragma unroll
    for (int k = 0; k < 4; ++k) { const int i = tid + 512 * k, e = i >> 4, c = i & 15; lds_st16(lds, e * 256 + ((c ^ (e & 7)) << 4), R.v[k]); }
#pragma unroll
    for (int k = 0; k < 2; ++k) { const int i = tid + 512 * k, d = i >> 4, c = i & 15; lds_st16(lds, 32768 + d * 256 + ((c ^ (d & 7)) << 4), R.k[k]); }
}
__device__ __forceinline__ void kv_compute(LAS unsigned char* lds, int uid, bf16_t* __restrict__ kvbuf, const float* dfp, const float* dbp, int lane, int wave) {
    const int sqc = uid >> 2, h = uid & 3;
    const float lf = logsig(dfp[h]), lb = logsig(dbp[h]);
    const int fr = lane & 15, fq = lane >> 4, e0 = wave * 16;
    float pjf[8], pjb[8];
#pragma unroll
    for (int i = 0; i < 8; ++i) { pjf[i] = __expf(-(float)i * lf); pjb[i] = __expf((float)i * lb); }
    const int vo0 = fr * 256 + (((fq) ^ (fr & 7)) << 4), vo1 = fr * 256 + (((4 + fq) ^ (fr & 7)) << 4);
    f32x4 af[4], ab[4];
#pragma unroll
    for (int dt = 0; dt < 4; ++dt) { af[dt] = (f32x4){0.f, 0.f, 0.f, 0.f}; ab[dt] = (f32x4){0.f, 0.f, 0.f, 0.f}; }
#pragma unroll
    for (int ks = 0; ks < 4; ++ks) { const int vo = ((ks & 1) ? vo1 : vo0) + (ks >> 1) * 128;
        const bf16x8 a = lds_ld16(lds, e0 * 256 + vo);
        const int s0 = ks * 32 + fq * 8;
        const bf16x8 a_f = scale_frag8(a, __expf((float)(127 - s0) * lf), pjf), a_b = scale_frag8(a, __expf((float)s0 * lb), pjb);
#pragma unroll
        for (int dt = 0; dt < 4; ++dt) { const bf16x8 kb = lds_ld16(lds, 32768 + dt * 4096 + vo); af[dt] = mfma16(a_f, kb, af[dt]); ab[dt] = mfma16(a_b, kb, ab[dt]); } }
    bf16_t* of = kvbuf + ((size_t)sqc * 4 + h) * 8192, *ob = kvbuf + ((size_t)(NCH + sqc) * 4 + h) * 8192;
#pragma unroll
    for (int dt = 0; dt < 4; ++dt)
#pragma unroll
        for (int r = 0; r < 4; ++r) { of[(e0 + fq * 4 + r) * 64 + dt * 16 + fr] = (bf16_t)f2bf(af[dt][r]); ob[(e0 + fq * 4 + r) * 64 + dt * 16 + fr] = (bf16_t)f2bf(ab[dt][r]); }
}
__device__ __forceinline__ void kv_phase(LAS unsigned char* lds, int ufirst, int nunits, const bf16_t* __restrict__ vt, const bf16_t* __restrict__ kt, bf16_t* __restrict__ kvbuf, const float* dfp, const float* dbp, int tid, int lane, int wave) {
    int u = ufirst;
    if (u >= nunits) return;
    KvRegs R; kv_load(R, u, vt, kt, tid);
    for (; u < nunits; u += gridDim.x) {
        __syncthreads();
        kv_store(R, lds, tid);
        __syncthreads();
        const int un = u + gridDim.x;
        if (un < nunits) kv_load(R, un, vt, kt, tid);
        kv_compute(lds, u, kvbuf, dfp, dbp, lane, wave);
    }
    __syncthreads();
}

__device__ __forceinline__ void scan_phase(const bf16_t* __restrict__ kv, bf16_t* __restrict__ sp, const float* dfp, const float* dbp, bool ctx_out, int tid) {
    const int gt = blockIdx.x * NTHREADS + tid, NT = gridDim.x * NTHREADS;
    for (int idx = gt; idx < 2 * 4 * 4 * 2048; idx += NT) {
        const int elem = (idx & 2047) * 4, h = (idx >> 11) & 3, b = (idx >> 13) & 3, dir = idx >> 15;
        const float G = __expf(128.f * logsig(dir ? dbp[h] : dfp[h]));
        const bf16_t* base = kv + (size_t)dir * NCH * 4 * 8192 + (size_t)h * 8192 + elem;
        bf16_t* spb = sp + (size_t)dir * NCH * 4 * 8192 + (size_t)h * 8192 + elem;
        const size_t CS = 4 * 8192;
        const u32x2 c0 = *(const u32x2*)(base + (size_t)(256 + b * 2) * CS), c1 = *(const u32x2*)(base + (size_t)(256 + b * 2 + 1) * CS);
        float S0, S1, S2, S3;
        if (dir == 0) { S0 = G * bflo(c0.x) + bflo(c1.x); S1 = G * bfhi(c0.x) + bfhi(c1.x); S2 = G * bflo(c0.y) + bflo(c1.y); S3 = G * bfhi(c0.y) + bfhi(c1.y); }
        else { S0 = bflo(c0.x) + G * bflo(c1.x); S1 = bfhi(c0.x) + G * bfhi(c1.x); S2 = bflo(c0.y) + G * bflo(c1.y); S3 = bfhi(c0.y) + G * bfhi(c1.y); }
        const int nstart = dir == 0 ? 0 : 63, nstep = dir == 0 ? 1 : -1;
#pragma unroll 1
        for (int nb = 0; nb < 64; nb += 32) {
            u32x2 v[32];
#pragma unroll
            for (int j = 0; j < 32; ++j) v[j] = *(const u32x2*)(base + (size_t)(b * 64 + nstart + nstep * (nb + j)) * CS);
#pragma unroll
            for (int j = 0; j < 32; ++j) { u32x2 w; w.x = pk2(S0, S1); w.y = pk2(S2, S3); *(u32x2*)(spb + (size_t)(b * 64 + nstart + nstep * (nb + j)) * CS) = w;
                S0 = G * S0 + bflo(v[j].x); S1 = G * S1 + bfhi(v[j].x); S2 = G * S2 + bflo(v[j].y); S3 = G * S3 + bfhi(v[j].y); }
        }
        if (ctx_out) {
            const u32x2 z = (u32x2){0u, 0u};
            if (dir == 0) { *(u32x2*)(spb + (size_t)(256 + b * 2) * CS) = z; *(u32x2*)(spb + (size_t)(256 + b * 2 + 1) * CS) = c0; }
            else { *(u32x2*)(spb + (size_t)(256 + b * 2 + 1) * CS) = z; *(u32x2*)(spb + (size_t)(256 + b * 2) * CS) = c1; }
        }
    }
}

__device__ __forceinline__ bf16x8 scale_frag(bf16x8 a, float sc) {
    const u32x4 u = __builtin_bit_cast(u32x4, a); f32x8 f = unpack8(u);
#pragma unroll
    for (int i = 0; i < 8; ++i) f[i] *= sc;
    return __builtin_bit_cast(bf16x8, pack8(f));
}
constexpr int RO_KS = 0, RO_VS = 16384, RO_SF = 49152, RO_SB = 65536;
struct RoRegs { u32x4 k[2], v[4], f[2], b[2]; };
__device__ __forceinline__ void ro_load(RoRegs& R, int uid, const bf16_t* __restrict__ proj, const bf16_t* __restrict__ vt, const bf16_t* __restrict__ sp, int tid) {
    const int sqc = uid >> 2, h = uid & 3, row0 = sqc * 128;
#pragma unroll
    for (int k = 0; k < 2; ++k) { const int i = tid + 512 * k, r = i >> 3, c = i & 7;
        R.k[k] = *(const u32x4*)(proj + (size_t)(row0 + r) * INW + C_KR + h * 64 + c * 8);
        R.f[k] = *(const u32x4*)(sp + ((size_t)sqc * 4 + h) * 8192 + r * 64 + c * 8);
        R.b[k] = *(const u32x4*)(sp + ((size_t)(NCH + sqc) * 4 + h) * 8192 + r * 64 + c * 8); }
#pragma unroll
    for (int k = 0; k < 4; ++k) { const int i = tid + 512 * k, e = i >> 4, c = i & 15;
        R.v[k] = *(const u32x4*)(vt + (size_t)(128 + h * 128 + e) * TROWS + row0 + c * 8); }
}
__device__ __forceinline__ void ro_store(const RoRegs& R, LAS unsigned char* lds, int tid) {
#pragma unroll
    for (int k = 0; k < 2; ++k) { const int i = tid + 512 * k, r = i >> 3, c = i & 7, o = r * 128 + ((c ^ (r & 7)) << 4);
        lds_st16(lds, RO_KS + o, R.k[k]); lds_st16(lds, RO_SF + o, R.f[k]); lds_st16(lds, RO_SB + o, R.b[k]); }
#pragma unroll
    for (int k = 0; k < 4; ++k) { const int i = tid + 512 * k, e = i >> 4, c = i & 15;
        lds_st16(lds, RO_VS + e * 256 + ((c ^ (e & 7)) << 4), R.v[k]); }
}
__device__ __forceinline__ void retout_compute(LAS unsigned char* lds, int uid, const bf16_t* __restrict__ proj, bf16_t* __restrict__ mix, const float* dfp, const float* dbp, const float* gnp, int lane, int wave) {
    const int sqc = uid >> 2, h = uid & 3;
    const int row0 = sqc * 128;
    const float l2f = logsig(dfp[h]) * 1.4426950408889634f, l2b = logsig(dbp[h]) * 1.4426950408889634f;
    const int fr = lane & 15, fq = lane >> 4, q0 = wave * 16;
    const size_t qrow = (size_t)(row0 + q0 + fr);
    const bf16_t* qp = proj + qrow * INW + C_QR + h * 64 + fq * 8;
    const bf16x8 aq0 = gld16(qp), aq1 = gld16(qp + 32);
    u32x2 gw[8];
#pragma unroll
    for (int et = 0; et < 8; ++et) gw[et] = *(const u32x2*)(proj + qrow * INW + C_GR + h * 128 + et * 16 + fq * 4);
    const int kr0 = (fr >> 2) * 8 + (fr & 3);
    const int ko00 = kr0 * 128 + (((fq) ^ (kr0 & 7)) << 4), ko01 = kr0 * 128 + (((4 + fq) ^ (kr0 & 7)) << 4);
    const int ko10 = (kr0 + 4) * 128 + (((fq) ^ ((kr0 + 4) & 7)) << 4), ko11 = (kr0 + 4) * 128 + (((4 + fq) ^ ((kr0 + 4) & 7)) << 4);
    const int fo0 = fr * 128 + (((fq) ^ (fr & 7)) << 4), fo1 = fr * 128 + (((4 + fq) ^ (fr & 7)) << 4);
    const int vo0 = fr * 256 + (((fq) ^ (fr & 7)) << 4), vo1 = fr * 256 + (((4 + fq) ^ (fr & 7)) << 4);
    bf16x8 wb[4];
#pragma unroll
    for (int pi = 0; pi < 4; ++pi) {
        f32x4 s0 = mfma16(lds_ld16(lds, RO_KS + pi * 4096 + ko00), aq0, (f32x4){0.f, 0.f, 0.f, 0.f}); s0 = mfma16(lds_ld16(lds, RO_KS + pi * 4096 + ko01), aq1, s0);
        f32x4 s1 = mfma16(lds_ld16(lds, RO_KS + pi * 4096 + ko10), aq0, (f32x4){0.f, 0.f, 0.f, 0.f}); s1 = mfma16(lds_ld16(lds, RO_KS + pi * 4096 + ko11), aq1, s1);
        const int d0 = (q0 + fr) - (pi * 32 + fq * 8);
#pragma unroll
        for (int r = 0; r < 4; ++r) { const int da = d0 - r, db = d0 - 4 - r;
            s0[r] *= da >= 0 ? __builtin_amdgcn_exp2f((float)da * l2f) : __builtin_amdgcn_exp2f((float)(-da) * l2b);
            s1[r] *= db >= 0 ? __builtin_amdgcn_exp2f((float)db * l2f) : __builtin_amdgcn_exp2f((float)(-db) * l2b); }
        u32x4 w; w.x = pk2(s0[0], s0[1]); w.y = pk2(s0[2], s0[3]); w.z = pk2(s1[0], s1[1]); w.w = pk2(s1[2], s1[3]);
        wb[pi] = __builtin_bit_cast(bf16x8, w);
    }
    const float xf = __builtin_amdgcn_exp2f((float)(q0 + fr + 1) * l2f), xb = __builtin_amdgcn_exp2f((float)(128 - (q0 + fr)) * l2b);
    const bf16x8 qsf0 = scale_frag(aq0, xf), qsf1 = scale_frag(aq1, xf), qsb0 = scale_frag(aq0, xb), qsb1 = scale_frag(aq1, xb);
    f32x4 o[8];
#pragma unroll
    for (int et = 0; et < 8; ++et) {
        f32x4 acc = mfma16(lds_ld16(lds, RO_VS + et * 4096 + vo0), wb[0], (f32x4){0.f, 0.f, 0.f, 0.f});
        acc = mfma16(lds_ld16(lds, RO_VS + et * 4096 + vo1), wb[1], acc);
        acc = mfma16(lds_ld16(lds, RO_VS + et * 4096 + 128 + vo0), wb[2], acc);
        acc = mfma16(lds_ld16(lds, RO_VS + et * 4096 + 128 + vo1), wb[3], acc);
        acc = mfma16(lds_ld16(lds, RO_SF + et * 2048 + fo0), qsf0, acc); acc = mfma16(lds_ld16(lds, RO_SF + et * 2048 + fo1), qsf1, acc);
        acc = mfma16(lds_ld16(lds, RO_SB + et * 2048 + fo0), qsb0, acc); acc = mfma16(lds_ld16(lds, RO_SB + et * 2048 + fo1), qsb1, acc);
        o[et] = acc;
    }
    float sm = 0.f;
#pragma unroll
    for (int et = 0; et < 8; ++et) sm += (o[et][0] + o[et][1]) + (o[et][2] + o[et][3]);
    const float mu = sum4q(sm) * (1.f / 128.f);
    float vs = 0.f;
#pragma unroll
    for (int et = 0; et < 8; ++et)
#pragma unroll
        for (int r = 0; r < 4; ++r) { const float dd = o[et][r] - mu; vs += dd * dd; }
    const float rstd = __builtin_amdgcn_rsqf(sum4q(vs) * (1.f / 128.f) + GN_EPS);
    bf16_t* mp = mix + qrow * DM + 512 + h * 128 + fq * 4; const float* gg = gnp + h * 128 + fq * 4;
#pragma unroll
    for (int et = 0; et < 8; ++et) { const f32x4 gn = *(const f32x4*)(gg + et * 16);
        const float g0 = bflo(gw[et].x), g1 = bfhi(gw[et].x), g2 = bflo(gw[et].y), g3 = bfhi(gw[et].y);
        u32x2 w; w.x = pk2((o[et][0] - mu) * rstd * gn[0] * silu_f(g0), (o[et][1] - mu) * rstd * gn[1] * silu_f(g1));
        w.y = pk2((o[et][2] - mu) * rstd * gn[2] * silu_f(g2), (o[et][3] - mu) * rstd * gn[3] * silu_f(g3));
        *(u32x2*)(mp + et * 16) = w; }
}
__device__ __forceinline__ void retout_phase(LAS unsigned char* lds, int nunits, const bf16_t* __restrict__ proj, const bf16_t* __restrict__ vt, bf16_t* __restrict__ mix, const bf16_t* __restrict__ sp,
                                             const float* dfp, const float* dbp, const float* gnp, int tid, int lane, int wave) {
    int u = blockIdx.x;
    if (u >= nunits) return;
    RoRegs R; ro_load(R, u, proj, vt, sp, tid);
    for (; u < nunits; u += gridDim.x) {
        __syncthreads();
        ro_store(R, lds, tid);
        __syncthreads();
        const int un = u + gridDim.x;
        if (un < nunits) ro_load(R, un, proj, vt, sp, tid);
        retout_compute(lds, u, proj, mix, dfp, dbp, gnp, lane, wave);
    }
}

#define XB_TMO      128
#define XB_XCNT(j)  (256  + 64 * (j))
#define XB_XSUB(j)  (1280 + 64 * (j))
#define XB_XGEN(j)  (2304 + 64 * (j))
#define XB_TOP      3328
#define XB_TOPGEN   3392
#define XCD_BAR_WORDS 3456
#define XB_SPIN_CAP (1u << 22)
__device__ __forceinline__ unsigned xb_ld(unsigned* p)              { return __hip_atomic_load(p, __ATOMIC_RELAXED, __HIP_MEMORY_SCOPE_AGENT); }
__device__ __forceinline__ unsigned xb_add(unsigned* p, unsigned v) { return __hip_atomic_fetch_add(p, v, __ATOMIC_RELAXED, __HIP_MEMORY_SCOPE_AGENT); }
__device__ __forceinline__ unsigned xb_xcc_id() { return (unsigned)__builtin_amdgcn_s_getreg((3 << 11) | 20) & 0xFu; }
#define XB_SPIN(cond, bar) do { unsigned _sp = 0; while (cond) { \
    if ((++_sp & 255u) == 0u) { if (xb_ld(&(bar)[XB_TMO])) break; if (_sp > XB_SPIN_CAP) { atomicAdd(&(bar)[XB_TMO], 1u); break; } } } } while (0)
struct XcdBarrier { unsigned* bar; unsigned x; volatile LAS unsigned* st; };
__device__ __forceinline__ XcdBarrier xcd_barrier_post(unsigned* bar, volatile LAS unsigned* st) {
    XcdBarrier b; b.bar = bar; b.x = xb_xcc_id(); b.st = st;
    if (threadIdx.x == 0) (void)xb_add(&bar[XB_XCNT(b.x)], 1u);
    return b;
}
__device__ __forceinline__ void xcd_barrier_complete(unsigned* bar, unsigned x, unsigned& nloc, unsigned& nx) {
    const unsigned G = gridDim.x * gridDim.y * gridDim.z;
    unsigned sum, cnt, mine, sp = 0u;
    for (;;) {
        sum = 0u; cnt = 0u; mine = 0u;
#pragma unroll
        for (unsigned j = 0; j < 16; ++j) { const unsigned c = xb_ld(&bar[XB_XCNT(j)]); sum += c; cnt += (c > 0u) ? 1u : 0u; mine = (j == x) ? c : mine; }
        if (sum == G) break;
        __builtin_amdgcn_s_sleep(1);
        if ((++sp & 255u) == 0u) { if (xb_ld(&bar[XB_TMO])) break; if (sp > XB_SPIN_CAP) { atomicAdd(&bar[XB_TMO], 1u); break; } }
    }
    nloc = mine > 0u ? mine : 1u; nx = cnt > 0u ? cnt : 1u;
}
__device__ __forceinline__ void xcd_barrier(const XcdBarrier& b) {
    asm volatile("s_waitcnt vmcnt(0)" ::: "memory");
    __syncthreads();
    if (threadIdx.x == 0) {
        unsigned* bar = b.bar;
        __builtin_amdgcn_s_waitcnt(0);
        unsigned nloc = b.st[0], nx = b.st[1];
        if (nloc == 0u) { xcd_barrier_complete(bar, b.x, nloc, nx); b.st[0] = nloc; b.st[1] = nx; }
        const unsigned old = xb_add(&bar[XB_XSUB(b.x)], 1u);
        const unsigned gen = old / nloc;
        if (old + 1u == (gen + 1u) * nloc) {
            __builtin_amdgcn_fence(__ATOMIC_RELEASE, "agent");
            asm volatile("s_waitcnt vmcnt(0)" ::: "memory");
            const unsigned og = xb_add(&bar[XB_TOP], 1u);
            const unsigned tg = og / nx;
            if (og + 1u == (tg + 1u) * nx) xb_add(&bar[XB_TOPGEN], 1u);
            else XB_SPIN(xb_ld(&bar[XB_TOPGEN]) == tg, bar);
            __builtin_amdgcn_fence(__ATOMIC_ACQUIRE, "agent");
            xb_add(&bar[XB_XGEN(b.x)], 1u);
            asm volatile("s_waitcnt vmcnt(0)" ::: "memory");
        } else {
            XB_SPIN(xb_ld(&bar[XB_XGEN(b.x)]) == gen, bar);
            __builtin_amdgcn_fence(__ATOMIC_ACQUIRE, "agent");
            asm volatile("s_waitcnt vmcnt(0)" ::: "memory");
        }
    }
    __syncthreads();
}


struct AnyOrder {
    pg8::StaticOrder so; int S, pm0, nN, nwg, G, c;
    __device__ __forceinline__ void init_static(int M, int N, int G_, int c_) { so.init(M, N, G_, c_); S = 1; pm0 = 0; nN = 0; nwg = 0; G = G_; c = c_; }
    __device__ __forceinline__ void init_split(int pm0_, int nMt, int nN_, int S_, int G_, int c_) { so.init(0, 0, G_, c_); S = S_; pm0 = pm0_; nN = nN_; nwg = nMt * nN_ * S_; G = G_; c = c_; }
    __device__ __forceinline__ bool next(int i, pg8::Unit& u) const {
        if (S == 1) return so.next(i, u);
        const int L = i * G + c; if (L >= nwg) return false;
        const int t = L / S; u.ks = L - t * S; u.pn = t % nN; u.pm = pm0 + t / nN; return true;
    }
    __device__ __forceinline__ void a_ready(const pg8::Unit&) const {}
    __device__ __forceinline__ void done(const pg8::Unit&) const {}
};
struct EpiAny {
    static constexpr bool PERM = true, AFTER_DRAIN = false;
    bf16_t* O; int ldc; int mode; unsigned char* ws;
    __device__ __forceinline__ void operator()(const f32x4 (&acc)[2][2][4][2], const pg8::Unit& u, int wr, int wc, int fr, int fq) const {
        const int row0 = u.pm * 256 + wr * 64 + fr;
        if (mode == 2) {
            const int col0 = u.pn * 256 + wc * 32 + 8 * fq;
            const bool lat = u.pm < NLAT / 256;
#pragma unroll
            for (int ai = 0; ai < 2; ++ai)
#pragma unroll
                for (int m = 0; m < 4; ++m) { const int row = row0 + ai * 128 + m * 16, pos = row & (SEQ - 1);
                    bf16_t* rowp = O + (size_t)row * INW + col0;
#pragma unroll
                    for (int bj = 0; bj < 2; ++bj) { f32x4 v0 = acc[ai][bj][m][0], v1 = acc[ai][bj][m][1];
                        const int cb = u.pn * 256 + bj * 128 + wc * 32;
                        if (lat && (cb < C_VA || (cb >= C_QR && cb < C_VR))) {
                            const f32x2* cs = (cb < C_VA) ? (const f32x2*)(ws + WS_AX) + (((wc & 1) ? 128 + (pos & 63) : (pos >> 6)) * 16 + 4 * fq) : (const f32x2*)(ws + WS_RET) + ((size_t)pos * 32 + 16 * (wc & 1) + 4 * fq);
                            const f32x4 t01 = *(const f32x4*)cs, t23 = *(const f32x4*)(cs + 2);
                            const float c0 = t01.x, s0 = t01.y, c1 = t01.z, s1 = t01.w, c2 = t23.x, s2 = t23.y, c3 = t23.z, s3 = t23.w;
                            const f32x4 x1 = v0, x2 = v1;
                            v0[0] = x1[0] * c0 - x2[0] * s0; v1[0] = x2[0] * c0 + x1[0] * s0;
                            v0[1] = x1[1] * c1 - x2[1] * s1; v1[1] = x2[1] * c1 + x1[1] * s1;
                            v0[2] = x1[2] * c2 - x2[2] * s2; v1[2] = x2[2] * c2 + x1[2] * s2;
                            v0[3] = x1[3] * c3 - x2[3] * s3; v1[3] = x2[3] * c3 + x1[3] * s3;
                        }
                        const bool isV = (cb >= C_VA && cb < C_QR) || (cb >= C_VR && cb < C_GR), isKr = (cb >= C_KR && cb < C_VR);
                        if (!isV) { u32x4 w; w.x = pk2(v0[0], v0[1]); w.y = pk2(v0[2], v0[3]); w.z = pk2(v1[0], v1[1]); w.w = pk2(v1[2], v1[3]);
                            *(u32x4*)(rowp + bj * 128) = w; }
                        if (isV || isKr) {
                            bf16_t* tp = isV ? (bf16_t*)(ws + WS_VT) + (size_t)((cb >= C_VR ? cb - C_VR + 128 : cb - C_VA) + 8 * fq) * TROWS + row
                                             : (bf16_t*)(ws + WS_KT) + (size_t)(cb - C_KR + 8 * fq) * TROWS + row;
                            tp[0] = (bf16_t)f2bf(v0[0]); tp[TROWS] = (bf16_t)f2bf(v0[1]); tp[2 * TROWS] = (bf16_t)f2bf(v0[2]); tp[3 * TROWS] = (bf16_t)f2bf(v0[3]);
                            tp[4 * (size_t)TROWS] = (bf16_t)f2bf(v1[0]); tp[5 * (size_t)TROWS] = (bf16_t)f2bf(v1[1]); tp[6 * (size_t)TROWS] = (bf16_t)f2bf(v1[2]); tp[7 * (size_t)TROWS] = (bf16_t)f2bf(v1[3]); }
                    } }
        } else if (mode == 3) {
            const int col0 = u.pn * 256 + wc * 32 + 8 * fq;
            bf16_t* P = (bf16_t*)(ws + WS_PART) + (size_t)u.ks * NCTX * DM;
#pragma unroll
            for (int ai = 0; ai < 2; ++ai)
#pragma unroll
                for (int m = 0; m < 4; ++m) { bf16_t* rowp = P + (size_t)(row0 + ai * 128 + m * 16 - NLAT) * DM + col0;
#pragma unroll
                    for (int bj = 0; bj < 2; ++bj) { const f32x4 v0 = acc[ai][bj][m][0], v1 = acc[ai][bj][m][1];
                        u32x4 w; w.x = pk2(v0[0], v0[1]); w.y = pk2(v0[2], v0[3]); w.z = pk2(v1[0], v1[1]); w.w = pk2(v1[2], v1[3]);
                        *(u32x4*)(rowp + bj * 128) = w; } }
        } else if (mode == 0) {
            const int col0 = u.pn * 256 + wc * 32 + 8 * fq;
#pragma unroll
            for (int ai = 0; ai < 2; ++ai)
#pragma unroll
                for (int m = 0; m < 4; ++m) { bf16_t* rowp = O + (size_t)(row0 + ai * 128 + m * 16) * ldc + col0;
#pragma unroll
                    for (int bj = 0; bj < 2; ++bj) { const f32x4 v0 = acc[ai][bj][m][0], v1 = acc[ai][bj][m][1];
                        u32x4 w; w.x = pk2(v0[0], v0[1]); w.y = pk2(v0[2], v0[3]); w.z = pk2(v1[0], v1[1]); w.w = pk2(v1[2], v1[3]);
                        *(u32x4*)(rowp + bj * 128) = w; } }
        } else {
            const int col0 = u.pn * 128 + wc * 32 + 8 * fq;
#pragma unroll
            for (int ai = 0; ai < 2; ++ai)
#pragma unroll
                for (int m = 0; m < 4; ++m) { bf16_t* rowp = O + (size_t)(row0 + ai * 128 + m * 16) * DFF + col0;
                    const f32x4 a0 = acc[ai][0][m][0], a1 = acc[ai][0][m][1], b0 = acc[ai][1][m][0], b1 = acc[ai][1][m][1];
                    u32x4 w; w.x = pk2(silu_f(a0[0]) * b0[0], silu_f(a0[1]) * b0[1]); w.y = pk2(silu_f(a0[2]) * b0[2], silu_f(a0[3]) * b0[3]);
                    w.z = pk2(silu_f(a1[0]) * b1[0], silu_f(a1[1]) * b1[1]); w.w = pk2(silu_f(a1[2]) * b1[2], silu_f(a1[3]) * b1[3]);
                    *(u32x4*)rowp = w; }
        }
    }
};

__global__ void __launch_bounds__(NTHREADS) fwd_megakernel(Params p) {
    extern __shared__ __attribute__((aligned(16))) unsigned char smem[];
    LAS unsigned char* lds = (LAS unsigned char*)smem;
    cg::grid_group grid = cg::this_grid();
    constexpr int NSTEPS = 2 + 2 * 12;
    {
        int tid0 = threadIdx.x; asm volatile("" : "+v"(tid0));
        if (tid0 == 0) { ((volatile LAS unsigned*)(lds + LDS_BYTES - 64))[0] = 0u; ((volatile LAS unsigned*)(lds + LDS_BYTES - 64))[1] = 0u; }
    }
    const XcdBarrier xbar = xcd_barrier_post((unsigned*)(p.ws + WS_BAR), (volatile LAS unsigned*)(lds + LDS_BYTES - 64));
    {
        int tid0 = threadIdx.x; asm volatile("" : "+v"(tid0));
        p0_phase(p, lds, tid0, tid0 & 63, __builtin_amdgcn_readfirstlane(tid0 >> 6));
        if (p.ws == nullptr) grid.sync();
        xcd_barrier(xbar);
    }
#pragma unroll 1
    for (int st = 1; st < NSTEPS; ++st) {
        int tid = threadIdx.x; asm volatile("" : "+v"(tid));
        const int lane = tid & 63, wave = __builtin_amdgcn_readfirstlane(tid >> 6);
        unsigned char* ws = p.ws;
        const float* mod = (const float*)(ws + WS_MOD);
        const f32x2* rettab = (const f32x2*)(ws + WS_RET);
        const f32x2* axtab = (const f32x2*)(ws + WS_AX);
        bf16_t* hb = (bf16_t*)(ws + WS_H);
        bf16_t* ub = (bf16_t*)(ws + WS_U);
        bf16_t* yb = (bf16_t*)(ws + WS_Y);
        bf16_t* mixb = (bf16_t*)(ws + WS_U);
        bf16_t* actb = (bf16_t*)(ws + WS_ACT);
        bf16_t* projb = actb;
        bf16_t* kvb = (bf16_t*)(ws + WS_KV);
        bf16_t* spb = (bf16_t*)(ws + WS_SP);
        const bf16_t* vtb = (const bf16_t*)(ws + WS_VT); const bf16_t* ktb = (const bf16_t*)(ws + WS_KT);
        const float* npre = p.in[6]; const float* npost = p.in[7];
        {
            const int l = st < 2 ? 0 : (st - 2) / 12, k = st < 2 ? -1 : (st - 2) % 12;
            const bool last = (l == 1);
            const bf16_t* wl = (const bf16_t*)(ws + WS_W + (size_t)l * SZ_WL);
            const float* modl = mod + (size_t)l * 5 * NMODC;
            const int MR = last ? NLAT : TROWS;
            if (k == 0 || k == 1 || k == 3 || k == 7 || k == 9 || k == 10) {
                const bf16_t* A; const bf16_t* B; bf16_t* O; int M, N, K, ldc, mode;
                if (k == 0)      { A = ub;   B = wl + OW_WI1 / 2;  O = actb;  M = TROWS; N = NWI; K = DM;  ldc = DFF; mode = 1; }
                else if (k == 1) { A = actb; B = wl + OW_WO1 / 2;  O = yb;    M = NLAT;  N = DM;  K = DFF; ldc = DM;  mode = 0; }
                else if (k == 3) { A = ub;   B = wl + OW_WIN / 2;  O = projb; M = TROWS; N = INW; K = DM;  ldc = INW; mode = 2; }
                else if (k == 7) { A = mixb; B = wl + OW_WOUT / 2; O = yb;    M = NLAT;  N = DM;  K = DM;  ldc = DM;  mode = 0; }
                else if (k == 9) { A = ub;   B = wl + OW_WI2 / 2;  O = actb;  M = MR;    N = NWI; K = DM;  ldc = DFF; mode = 1; }
                else             { A = actb; B = wl + OW_WO2 / 2;  O = yb;    M = NLAT;  N = DM;  K = DFF; ldc = DM;  mode = 0; }
                {
                    pg8::Gemm g{A, B, M, N, K, K, 0}; AnyOrder S; S.init_static(M, N, (int)gridDim.x, (int)blockIdx.x);
                    EpiAny E{O, ldc, mode, ws};
                    pg8::gemm_phase<EpiAny, AnyOrder, true, true>(lds, g, S, E);
                }
                if ((k == 1 || k == 7 || k == 10) && (k == 1 || !last)) {
                    pg8::Gemm g{A, B, TROWS, N, 256, K, 256}; AnyOrder S; S.init_split(NLAT / 256, NCTX / 256, N / 256, K / 256, (int)gridDim.x, (int)blockIdx.x);
                    EpiAny E{O, ldc, 3, ws};
                    pg8::gemm_phase<EpiAny, AnyOrder, true, true>(lds, g, S, E);
                }
            } else if (k == -1 || k == 2 || k == 8 || k == 11) {
                const bf16_t* y = (k == -1) ? nullptr : yb;
                const bool first = (l == 0 && k <= 2);
                const float* hs_lat = first ? p.in[0] : nullptr; const float* hs_ctx = first ? p.in[2] : nullptr;
                int nrows, gate_idx, post_i, shift_idx, scale_idx, pre_i; float rs; bool do_u = true; const float* mod_u = modl;
                if (k == -1)     { nrows = TROWS; gate_idx = 0; post_i = 0;         rs = 0.f;  shift_idx = 0; scale_idx = 1; pre_i = 0; }
                else if (k == 2) { nrows = TROWS; gate_idx = 2; post_i = l * 3 + 0; rs = 0.5f; shift_idx = 3; scale_idx = 4; pre_i = l * 3 + 1; }
                else if (k == 8) { nrows = MR;    gate_idx = 5; post_i = l * 3 + 1; rs = 1.0f; shift_idx = 6; scale_idx = 7; pre_i = l * 3 + 2; }
                else             { nrows = MR;    gate_idx = 8; post_i = l * 3 + 2; rs = 0.5f; shift_idx = 0; scale_idx = 1; pre_i = last ? 0 : (l + 1) * 3; do_u = !last; mod_u = last ? modl : modl + 5 * NMODC; }
                if (k == -1) prenorm_phase(nrows, p.in[0], p.in[2], mod_u, shift_idx, scale_idx, npre + pre_i * DM, ub, lane, wave);
                else if (first) norm_phase(nrows, y, (const bf16_t*)(ws + WS_PART), (k == 8) ? 4 : 11, hs_lat, hs_ctx, hb, (last && k == 11) ? p.out : nullptr, rs, modl, gate_idx, npost + post_i * DM, do_u, mod_u, shift_idx, scale_idx, npre + pre_i * DM, ub, lane, wave);
                else norm_phase8(nrows, y, (const bf16_t*)(ws + WS_PART), (k == 8) ? 4 : 11, hs_lat, hs_ctx, hb, (last && k == 11) ? p.out : nullptr, rs, modl, gate_idx, npost + post_i * DM, do_u, mod_u, shift_idx, scale_idx, npre + pre_i * DM, ub, lane, wave);
            } else if (k == 4) {
                const int NA = last ? 1024 : 1056;
                for (int u = blockIdx.x; u < NA; u += gridDim.x) attn_unit(lds, u, projb, vtb, mixb, p.in[14] + l * 8, tid, lane, wave);
                kv_phase(lds, (int)((blockIdx.x + gridDim.x / 2) % gridDim.x), NCH * 4, vtb, ktb, kvb, p.in[15] + l * 4, p.in[16] + l * 4, tid, lane, wave);
            } else if (k == 5) {
                scan_phase(kvb, spb, p.in[15] + l * 4, p.in[16] + l * 4, !last, tid);
            } else {
                const int NR = last ? 1024 : NCH * 4;
                retout_phase(lds, NR, projb, vtb, mixb, spb, p.in[15] + l * 4, p.in[16] + l * 4, p.in[17] + l * 512, tid, lane, wave);
            }
        }
        if (st + 1 < NSTEPS) xcd_barrier(xbar);
    }
}

extern "C" void kernel_launch(void* const* d_in, const int* in_sizes, int n_in, void* d_out, int out_size, void* d_ws, size_t ws_size, hipStream_t stream) {
    static int grid_blocks = 0;
    if (grid_blocks == 0) {
        if (n_in != 18 || ws_size < WS_END) { fprintf(stderr, "kernel_launch: unexpected n_in %d or workspace %zu < %zu\n", n_in, ws_size, (size_t)WS_END); grid_blocks = -1; return; }
        int dev = 0, cus = 0, per_cu = 0;
        hipGetDevice(&dev);
        hipDeviceGetAttribute(&cus, hipDeviceAttributeMultiprocessorCount, dev);
        if (hipFuncSetAttribute((const void*)fwd_megakernel, hipFuncAttributeMaxDynamicSharedMemorySize, LDS_BYTES) != hipSuccess) fprintf(stderr, "kernel_launch: hipFuncSetAttribute failed\n");
        if (hipOccupancyMaxActiveBlocksPerMultiprocessor(&per_cu, (const void*)fwd_megakernel, NTHREADS, LDS_BYTES) != hipSuccess || per_cu < 1) { fprintf(stderr, "kernel_launch: occupancy query gave %d\n", per_cu); per_cu = 1; }
        (void)hipGetLastError();
        grid_blocks = cus * 1;
        if (grid_blocks % 8) grid_blocks -= grid_blocks % 8;
    }
    if (grid_blocks < 0) return;
    if (hipMemsetAsync((char*)d_ws + WS_BAR, 0, XCD_BAR_WORDS * 4, stream) != hipSuccess) { fprintf(stderr, "kernel_launch: hipMemsetAsync of the barrier words failed\n"); return; }
    Params p{};
    for (int i = 0; i < 18; ++i) p.in[i] = (const float*)d_in[i];
    p.out = (float*)d_out; p.ws = (unsigned char*)d_ws;
    void* args[] = {&p};
    hipError_t e = hipLaunchCooperativeKernel((const void*)fwd_megakernel, dim3(grid_blocks), dim3(NTHREADS), args, LDS_BYTES, stream);
    if (e != hipSuccess) fprintf(stderr, "cooperative launch failed: %s (grid %d)\n", hipGetErrorString(e), grid_blocks);
}
```
